# Optimizing an MI355X kernel written in HIP

```python
import jax, jax.numpy as jnp
from jax import lax
import numpy as np


D_MODEL = 1024
BATCH = 16
SEQ = 4096
DEPTH = 4
DEC_BATCH = 16
DEC_SEQ = 2048
PAST_LEN = 128

N_MIXERS = 3
GRID_W = 64
EPS = 1e-6
FNET_GROUPS = 4
FNET_GROUP_DIM = D_MODEL // FNET_GROUPS
HEAD_DIM = 128
N_HEADS = D_MODEL // HEAD_DIM
N_KV_HEADS = 2
Q_PER_KV = N_HEADS // N_KV_HEADS
QKV_DIM = (N_HEADS + 2 * N_KV_HEADS) * HEAD_DIM
AXIS_ROT_DIM = HEAD_DIM // 2
ROPE_THETA = 10000.0
Q_BLOCK = 128
SGU_DIM = D_MODEL
SGU_GROUPS = 8
SGU_GROUP_DIM = SGU_DIM // SGU_GROUPS
SGU_CHUNK = 128
FFN_HIDDEN = -(-8 * D_MODEL // (3 * 256)) * 256

kernel_name = 'hybrid_fnet_gqa_gmlp_adaln_encoder'


def rms_norm(x, g):
    xf = x.astype(jnp.float32)
    y = xf * lax.rsqrt(jnp.mean(xf * xf, axis=-1, keepdims=True) + EPS)
    return (y * g.astype(jnp.float32)).astype(x.dtype)


def layer_norm(x, g, b):
    xf = x.astype(jnp.float32)
    mu = jnp.mean(xf, axis=-1, keepdims=True)
    xc = xf - mu
    y = xc * lax.rsqrt(jnp.mean(xc * xc, axis=-1, keepdims=True) + EPS)
    return (y * g.astype(jnp.float32) + b.astype(jnp.float32)).astype(x.dtype)


def modulate(h, shift, scale):
    return h * (1.0 + scale[:, None, :]) + shift[:, None, :]


def fourier_mixer(h, w_o):
    B, S, _ = h.shape
    hg = h.astype(jnp.float32).reshape(B, S, FNET_GROUPS, FNET_GROUP_DIM)
    f = jnp.fft.fftn(hg, axes=(1, 3), norm='ortho').real
    return f.reshape(B, S, D_MODEL).astype(h.dtype) @ w_o


def axial_rope_tables(S):
    rows = S // GRID_W
    row = jnp.repeat(jnp.arange(rows), GRID_W).astype(jnp.float32)
    col = jnp.tile(jnp.arange(GRID_W), rows).astype(jnp.float32)
    freqs = 1.0 / (ROPE_THETA ** (jnp.arange(0, AXIS_ROT_DIM, 2, dtype=jnp.float32) / AXIS_ROT_DIM))
    ang_r = row[:, None] * freqs[None, :]
    ang_c = col[:, None] * freqs[None, :]
    return jnp.cos(ang_r), jnp.sin(ang_r), jnp.cos(ang_c), jnp.sin(ang_c)


def rotate_half_rope(x, cos, sin):
    x1, x2 = jnp.split(x, 2, axis=-1)
    c = cos[:, None, :].astype(x.dtype)
    s = sin[:, None, :].astype(x.dtype)
    return jnp.concatenate([x1 * c - x2 * s, x2 * c + x1 * s], axis=-1)


def apply_axial_rope(x, tabs):
    cos_r, sin_r, cos_c, sin_c = tabs
    xr, xc = jnp.split(x, 2, axis=-1)
    return jnp.concatenate([rotate_half_rope(xr, cos_r, sin_r), rotate_half_rope(xc, cos_c, sin_c)], axis=-1)


def attention_mixer(h, w_qkv, q_g, k_g, w_o):
    B, S, _ = h.shape
    qkv = h @ w_qkv
    q, k, v = jnp.split(qkv, [N_HEADS * HEAD_DIM, (N_HEADS + N_KV_HEADS) * HEAD_DIM], axis=-1)
    q = rms_norm(q.reshape(B, S, N_HEADS, HEAD_DIM), q_g)
    k = rms_norm(k.reshape(B, S, N_KV_HEADS, HEAD_DIM), k_g)
    v = v.reshape(B, S, N_KV_HEADS, HEAD_DIM)
    tabs = axial_rope_tables(S)
    q = apply_axial_rope(q, tabs) * (HEAD_DIM ** -0.5)
    k = apply_axial_rope(k, tabs)
    nb = S // Q_BLOCK
    qb = q.reshape(B, nb, Q_BLOCK, N_KV_HEADS, Q_PER_KV, HEAD_DIM).transpose(1, 0, 2, 3, 4, 5)

    def block(qi):
        s = jnp.einsum('bqkgd,bskd->bkgqs', qi, k).astype(jnp.float32)
        p = jax.nn.softmax(s, axis=-1).astype(v.dtype)
        return jnp.einsum('bkgqs,bskd->bqkgd', p, v)

    o = lax.map(block, qb)
    o = o.transpose(1, 0, 2, 3, 4, 5).reshape(B, S, N_HEADS * HEAD_DIM)
    return o @ w_o


def spatial_gating_mixer(h, w_in, ln_g, ln_b, w_s, b_s, w_o):
    B, S, _ = h.shape
    uv = jax.nn.gelu(h @ w_in, approximate=False)
    u, v = jnp.split(uv, 2, axis=-1)
    v = layer_norm(v, ln_g, ln_b)
    nc = S // SGU_CHUNK
    vc = v.reshape(B, nc, SGU_CHUNK, SGU_GROUPS, SGU_GROUP_DIM)
    sv = jnp.einsum('gij,bnjgc->bnigc', w_s, vc) + b_s.T[None, None, :, :, None]
    return (u * sv.reshape(B, S, SGU_DIM)) @ w_o


def swiglu_ffn(h, w_gu, w_down):
    g, u = jnp.split(h @ w_gu, 2, axis=-1)
    return (jax.nn.silu(g) * u) @ w_down


def run_trunk(x, c, norm1_g, norm2_g, w_ada, b_ada, fnet_w_o, attn_w_qkv, attn_q_g, attn_k_g, attn_w_o,
              sgu_w_in, sgu_ln_g, sgu_ln_b, sgu_w_s, sgu_b_s, sgu_w_o, ffn_w_gu, ffn_w_down, final_g):
    cs = jax.nn.silu(c)
    for i in range(DEPTH):
        mod = cs @ w_ada[i] + b_ada[i]
        sh1, sc1, g1, sh2, sc2, g2 = jnp.split(mod, 6, axis=-1)
        h = modulate(rms_norm(x, norm1_g[i]), sh1, sc1)
        kind = i % N_MIXERS
        j = i // N_MIXERS
        if kind == 0:
            m = fourier_mixer(h, fnet_w_o[j])
        elif kind == 1:
            m = attention_mixer(h, attn_w_qkv[j], attn_q_g[j], attn_k_g[j], attn_w_o[j])
        else:
            m = spatial_gating_mixer(h, sgu_w_in[j], sgu_ln_g[j], sgu_ln_b[j], sgu_w_s[j], sgu_b_s[j], sgu_w_o[j])
        x = x + g1[:, None, :] * m
        h = modulate(rms_norm(x, norm2_g[i]), sh2, sc2)
        x = x + g2[:, None, :] * swiglu_ffn(h, ffn_w_gu[i], ffn_w_down[i])
    return rms_norm(x, final_g)


def setup_inputs(seed: int = 0) -> dict:
    key = jax.random.key(seed)
    ks = jax.random.split(key, 32)
    n_a = (DEPTH + 2) // 3
    n_b = (DEPTH + 1) // 3
    n_c = DEPTH // 3
    f32 = jnp.float32

    def nrm(k, shape, scale):
        return jax.random.normal(k, shape, f32) * scale

    D = D_MODEL
    return {
        'x_prompt': nrm(ks[0], (BATCH, SEQ, D), 1.0),
        'x_sample': nrm(ks[1], (DEC_BATCH, DEC_SEQ, D), 1.0),
        'c_prompt': nrm(ks[2], (BATCH, D), 1.0),
        'c_sample': nrm(ks[3], (DEC_BATCH, D), 1.0),
        'norm1_g': 1.0 + nrm(ks[4], (DEPTH, D), 0.02),
        'norm2_g': 1.0 + nrm(ks[5], (DEPTH, D), 0.02),
        'w_ada': nrm(ks[6], (DEPTH, D, 6 * D), 0.5 * D ** -0.5),
        'b_ada': nrm(ks[7], (DEPTH, 6 * D), 0.01),
        'fnet_w_o': nrm(ks[8], (n_a, D, D), D ** -0.5),
        'attn_w_qkv': nrm(ks[9], (n_b, D, QKV_DIM), D ** -0.5),
        'attn_q_g': 1.0 + nrm(ks[10], (n_b, HEAD_DIM), 0.02),
        'attn_k_g': 1.0 + nrm(ks[11], (n_b, HEAD_DIM), 0.02),
        'attn_w_o': nrm(ks[12], (n_b, N_HEADS * HEAD_DIM, D), (N_HEADS * HEAD_DIM) ** -0.5),
        'sgu_w_in': nrm(ks[13], (n_c, D, 2 * SGU_DIM), D ** -0.5),
        'sgu_ln_g': 1.0 + nrm(ks[14], (n_c, SGU_DIM), 0.02),
        'sgu_ln_b': nrm(ks[15], (n_c, SGU_DIM), 0.02),
        'sgu_w_s': nrm(ks[16], (n_c, SGU_GROUPS, SGU_CHUNK, SGU_CHUNK), 0.5 * SGU_CHUNK ** -0.5),
        'sgu_b_s': 1.0 + nrm(ks[17], (n_c, SGU_GROUPS, SGU_CHUNK), 0.02),
        'sgu_w_o': nrm(ks[18], (n_c, SGU_DIM, D), SGU_DIM ** -0.5),
        'ffn_w_gu': nrm(ks[19], (DEPTH, D, 2 * FFN_HIDDEN), D ** -0.5),
        'ffn_w_down': nrm(ks[20], (DEPTH, FFN_HIDDEN, D), FFN_HIDDEN ** -0.5),
        'final_g': 1.0 + nrm(ks[21], (D,), 0.02),
    }


def reference(x_prompt, x_sample, c_prompt, c_sample, norm1_g, norm2_g, w_ada, b_ada, fnet_w_o,
              attn_w_qkv, attn_q_g, attn_k_g, attn_w_o, sgu_w_in, sgu_ln_g, sgu_ln_b, sgu_w_s, sgu_b_s,
              sgu_w_o, ffn_w_gu, ffn_w_down, final_g):
    y_prompt = run_trunk(x_prompt, c_prompt, norm1_g, norm2_g, w_ada, b_ada, fnet_w_o, attn_w_qkv, attn_q_g,
                         attn_k_g, attn_w_o, sgu_w_in, sgu_ln_g, sgu_ln_b, sgu_w_s, sgu_b_s, sgu_w_o,
                         ffn_w_gu, ffn_w_down, final_g)
    y_sample = run_trunk(x_sample, c_sample, norm1_g, norm2_g, w_ada, b_ada, fnet_w_o, attn_w_qkv, attn_q_g,
                         attn_k_g, attn_w_o, sgu_w_in, sgu_ln_g, sgu_ln_b, sgu_w_s, sgu_b_s, sgu_w_o,
                         ffn_w_gu, ffn_w_down, final_g)
    return (y_prompt, y_sample)
```

```cpp
#include <hip/hip_runtime.h>
#include <hip/hip_cooperative_groups.h>
#include <cstdio>
#include <cstdint>
namespace cg = cooperative_groups;

#ifndef MK_EN
#define MK_EN 0xFFF
#endif
#define EN(k) (((MK_EN) >> (k)) & 1)
#ifndef MK_SINGLE
#define MK_SINGLE 1
#endif

#define LAS __attribute__((address_space(3)))
typedef unsigned short bf16_t;
typedef short bf16x8 __attribute__((ext_vector_type(8)));
typedef short s16x4 __attribute__((ext_vector_type(4)));
typedef float f32x2 __attribute__((ext_vector_type(2)));
typedef float f32x4 __attribute__((ext_vector_type(4)));
typedef float f32x16 __attribute__((ext_vector_type(16)));
typedef unsigned u32x2 __attribute__((ext_vector_type(2)));
typedef unsigned u32x4 __attribute__((ext_vector_type(4)));

constexpr int D = 1024, TP = 65536, TS = 32768, T = TP + TS, SP = 4096, SS = 2048, FF = 2816, NQKV = 1536, NMOD = 6144;
constexpr float EPS = 1e-6f;
constexpr int NWAVES = 8, NTHR = 512;
constexpr int LDS_BYTES = 147456;

__device__ __forceinline__ int seq_of(int row) { return row < TP ? (row >> 12) : 16 + ((row - TP) >> 11); }
__device__ __forceinline__ int seq_start(int s) { return s < 16 ? (s << 12) : TP + ((s - 16) << 11); }
__device__ __forceinline__ int seq_len(int s) { return s < 16 ? SP : SS; }
__device__ __forceinline__ size_t zt_base(int s) { return s < 16 ? (size_t)s * (1024u * 8192u) : (size_t)16 * (1024u * 8192u) + (size_t)(s - 16) * (1024u * 4096u); }

constexpr size_t MiB = 1u << 20;
constexpr size_t WS_MOD = 0;
constexpr size_t WS_DFTC = 3 * MiB;
constexpr size_t WS_WSB = WS_DFTC + 256 * 1024;
constexpr size_t WS_FNETW = 4 * MiB;
constexpr size_t WS_WQKV = 8 * MiB;
constexpr size_t WS_WAO = 11 * MiB;
constexpr size_t WS_WIN = 13 * MiB;
constexpr size_t WS_WSO = 17 * MiB;
constexpr size_t WS_WGU = 19 * MiB;
constexpr size_t WS_WDN = 63 * MiB;
constexpr size_t WS_SEQ4 = 85 * MiB;
constexpr size_t WS_SEQ2 = 149 * MiB;
constexpr size_t WS_H = 165 * MiB;
constexpr size_t WS_BIG = 357 * MiB;
constexpr size_t WS_END = 885 * MiB;

__device__ __forceinline__ unsigned f2bf(float f) { unsigned u = __builtin_bit_cast(unsigned, f); return (u + 0x7fffu + ((u >> 16) & 1u)) >> 16; }
__device__ __forceinline__ unsigned pk2(float lo, float hi) { return f2bf(lo) | (f2bf(hi) << 16); }
__device__ __forceinline__ float bf2f(unsigned short b) { return __builtin_bit_cast(float, ((unsigned)b) << 16); }
__device__ __forceinline__ unsigned cvt_pk_bf16(float lo, float hi) { unsigned r; asm volatile("v_cvt_pk_bf16_f32 %0, %1, %2" : "=v"(r) : "v"(lo), "v"(hi)); return r; }
__device__ __forceinline__ float wave_sum(float v) {
#pragma unroll
    for (int o = 1; o < 64; o <<= 1) v += __shfl_xor(v, o);
    return v;
}
__device__ __forceinline__ int tid_opaque() { int t = threadIdx.x; asm volatile("" : "+v"(t)); return t; }
#define LDS_WAIT() asm volatile("s_waitcnt lgkmcnt(0)" ::: "memory")

namespace pg8 {
constexpr int BM = 256, BK = 64, HALF = 128, HTB = HALF * BK * 2, STAGE_BYTES = 8 * HTB, NXCD = 8, WGM = 8;
__host__ __device__ __forceinline__ int lds_byte(int r, int c) { const int st = (r >> 4) * 2 + (c >> 5), rr = r & 15, cc = c & 31, ob = rr * 64 + cc * 2; return st * 1024 + (ob ^ (((ob >> 9) & 1) << 5)); }
__host__ __device__ __forceinline__ void stage_rc(int b, int& R, int& C) { const int st = b / 1024, sb = b % 1024, swz = sb ^ (((sb >> 9) & 1) << 5); R = (st >> 1) * 16 + swz / 64; C = (st & 1) * 32 + (swz % 64) / 2; }
__host__ __device__ __forceinline__ int perm32(int rho) { const int n = rho >> 4, i = rho & 15; return 8 * (i >> 2) + 4 * n + (i & 3); }

struct Unit { int pm, pn; };
struct Gemm { const bf16_t* A; const bf16_t* Bt; int lda, ldb, K, ash; size_t sA, sB; };

struct StaticOrder {
    int nM, nN, nwg, G, c;
    __device__ void init(int nM_, int nN_, int G_, int c_) { nM = nM_; nN = nN_; nwg = nM * nN; G = G_; c = c_; }
    __device__ bool next(int i, Unit& u) const {
        const long L = (long)i * G + c; if (L >= nwg) return false;
        int wgid = (int)L; { const int q = nwg / NXCD, r = nwg % NXCD, xcd = wgid % NXCD, off = wgid / NXCD; wgid = (xcd < r ? xcd * (q + 1) : r * (q + 1) + (xcd - r) * q) + off; }
        const int nig = WGM * nN, gid = wgid / nig, fm = gid * WGM, gsz = (nM - fm) < WGM ? (nM - fm) : WGM;
        u.pm = fm + ((wgid % nig) % gsz); u.pn = (wgid % nig) / gsz; return true;
    }
};

__device__ __forceinline__ f32x2 gelu_pk(f32x2 v) {
    const f32x2 av = __builtin_elementwise_abs(v), d = av * 0.2316418882f + 1.0f;
    f32x2 t; t.x = __builtin_amdgcn_rcpf(d.x); t.y = __builtin_amdgcn_rcpf(d.y);
    f32x2 q = t * 0.5307027145f + (-0.7265760135f); q = q * t + 0.7107068705f; q = q * t + (-0.142248368f); q = q * t + 0.127414796f; q = q * t;
    const f32x2 s = (v * v) * (-0.72134752044f);
    f32x2 e; e.x = __builtin_amdgcn_exp2f(s.x); e.y = __builtin_amdgcn_exp2f(s.y);
    const f32x2 m = v * (q * e), r = v - m;
    f32x2 o; o.x = v.x < 0.f ? m.x : r.x; o.y = v.y < 0.f ? m.y : r.y; return o;
}

template <int ACT> struct EpiBf16 {
    static constexpr bool PERM = true;
    bf16_t* O; int ldc; float scale;
    __device__ __forceinline__ void operator()(const f32x4 (&acc)[2][2][4][2], const Unit& u, int wr, int wc, int fr, int fq) const {
        const unsigned row0 = u.pm * BM + wr * 64 + fr, col0 = u.pn * BM + wc * 32 + 8 * fq;
        char* Ob = (char*)O;
#pragma unroll
        for (int ai = 0; ai < 2; ++ai)
#pragma unroll
            for (int m = 0; m < 4; ++m) { const unsigned ob = ((row0 + ai * HALF + m * 16) * (unsigned)ldc + col0) * 2u;
#pragma unroll
                for (int bj = 0; bj < 2; ++bj) { f32x4 v0 = acc[ai][bj][m][0], v1 = acc[ai][bj][m][1];
                    if (ACT == 1) { f32x2 a = gelu_pk((f32x2){v0[0], v0[1]}), b = gelu_pk((f32x2){v0[2], v0[3]}), c = gelu_pk((f32x2){v1[0], v1[1]}), d = gelu_pk((f32x2){v1[2], v1[3]});
                        v0 = (f32x4){a.x, a.y, b.x, b.y}; v1 = (f32x4){c.x, c.y, d.x, d.y}; }
                    v0 = v0 * scale; v1 = v1 * scale;
                    u32x4 w; w.x = cvt_pk_bf16(v0[0], v0[1]); w.y = cvt_pk_bf16(v0[2], v0[3]); w.z = cvt_pk_bf16(v1[0], v1[1]); w.w = cvt_pk_bf16(v1[2], v1[3]);
                    *(u32x4*)(Ob + (size_t)(ob + bj * HALF * 2)) = w; } }
    }
};
struct EpiChanDft {
    static constexpr bool PERM = true;
    bf16_t* Zt;
    __device__ __forceinline__ void operator()(const f32x4 (&acc)[2][2][4][2], const Unit& u, int wr, int wc, int fr, int fq) const {
        const int g = u.pm >> 1, cs = u.pm & 1, t0 = u.pn * BM, sq = seq_of(t0), S = seq_len(sq), s0 = t0 - seq_start(sq);
        const unsigned rs = 4u * (unsigned)S;
        char* lp = (char*)(Zt + zt_base(sq) + (size_t)cs * S + s0) + (size_t)((unsigned)(g * 256 + wr * 64 + fr) * rs + (unsigned)(wc * 32 + 8 * fq) * 2u);
#pragma unroll
        for (int ai = 0; ai < 2; ++ai)
#pragma unroll
            for (int m = 0; m < 4; ++m) { char* rp = lp + (size_t)((unsigned)(ai * HALF + m * 16) * rs);
#pragma unroll
                for (int bj = 0; bj < 2; ++bj) { const f32x4 v0 = acc[ai][bj][m][0] * 0.0625f, v1 = acc[ai][bj][m][1] * 0.0625f;
                    u32x4 w; w.x = cvt_pk_bf16(v0[0], v0[1]); w.y = cvt_pk_bf16(v0[2], v0[3]); w.z = cvt_pk_bf16(v1[0], v1[1]); w.w = cvt_pk_bf16(v1[2], v1[3]);
                    *(u32x4*)(rp + bj * HALF * 2) = w; }
                asm volatile("" ::: "memory"); }
    }
};
struct EpiSwiGlu {
    static constexpr bool PERM = true;
    bf16_t* Hd;
    __device__ __forceinline__ void operator()(const f32x4 (&acc)[2][2][4][2], const Unit& u, int wr, int wc, int fr, int fq) const {
        const unsigned row0 = u.pm * BM + wr * 64 + fr, col0 = u.pn * HALF + wc * 32 + 8 * fq;
        char* Hb = (char*)Hd;
#pragma unroll
        for (int ai = 0; ai < 2; ++ai)
#pragma unroll
            for (int m = 0; m < 4; ++m) { const unsigned ob = ((row0 + ai * HALF + m * 16) * (unsigned)FF + col0) * 2u;
                float o[8];
#pragma unroll
                for (int n = 0; n < 2; ++n)
#pragma unroll
                    for (int e = 0; e < 4; ++e) { const float gv = acc[ai][0][m][n][e], uv = acc[ai][1][m][n][e];
                        const float sg = gv * __builtin_amdgcn_rcpf(1.0f + __builtin_amdgcn_exp2f(-1.4426950408889634f * gv)); o[n * 4 + e] = sg * uv; }
                u32x4 w; w.x = cvt_pk_bf16(o[0], o[1]); w.y = cvt_pk_bf16(o[2], o[3]); w.z = cvt_pk_bf16(o[4], o[5]); w.w = cvt_pk_bf16(o[6], o[7]);
                *(u32x4*)(Hb + (size_t)ob) = w; }
    }
};
struct EpiResid {
    static constexpr bool PERM = false;
    const float* srcP; const float* srcS;
    float* out; const float* gate;
    __device__ __forceinline__ void operator()(const f32x4 (&acc)[2][2][4][2], const Unit& u, int wr, int wc, int fr, int fq) const {
        const unsigned row0 = u.pm * BM + wr * 64 + fr, col0 = u.pn * BM + wc * 32 + 4 * fq;
        const int sq = seq_of(u.pm * BM); const float* gp = gate + (size_t)sq * NMOD; const char* sb = (const char*)((u.pm * BM < TP) ? srcP : srcS); char* ob_ = (char*)out;
        f32x4 gv[2][2];
#pragma unroll
        for (int bj = 0; bj < 2; ++bj)
#pragma unroll
            for (int n = 0; n < 2; ++n) gv[bj][n] = *(const f32x4*)(gp + col0 + bj * HALF + n * 16);
#pragma unroll
        for (int ai = 0; ai < 2; ++ai)
#pragma unroll
            for (int m = 0; m < 4; ++m) { const unsigned off = ((row0 + ai * HALF + m * 16) * (unsigned)D + col0) * 4u;
#pragma unroll
                for (int bj = 0; bj < 2; ++bj)
#pragma unroll
                    for (int n = 0; n < 2; ++n) { const unsigned o2 = off + (bj * HALF + n * 16) * 4; const f32x4 xs = *(const f32x4*)(sb + (size_t)o2);
                        *(f32x4*)(ob_ + (size_t)o2) = xs + gv[bj][n] * acc[ai][bj][m][n]; }
                asm volatile("" ::: "memory"); }
    }
};

template <class Epi, class Sched, bool ALIGN_EPI, bool SP2>
__device__ __forceinline__ void gemm_phase(LAS unsigned char* lds, const Gemm g, const Sched& S, const Epi& E) {
    const int tid = tid_opaque(), wid = __builtin_amdgcn_readfirstlane(tid >> 6), lane = tid & 63, wr = wid >> 2, wc = wid & 3, fr = lane & 15, fq = lane >> 4;
    int K = g.K; asm volatile("" : "+s"(K));
    const int nt = K / BK;
    unsigned voffA[2], voffB[2];
#pragma unroll
    for (int i = 0; i < 2; ++i) { int R, C; stage_rc(tid * 16 + i * 8192, R, C); const int Rb = Epi::PERM ? ((R & ~31) + perm32(R & 31)) : R;
        voffA[i] = (unsigned)(R * g.lda + C) * 2u; voffB[i] = (unsigned)(Rb * g.ldb + C) * 2u; }
    const size_t kstep = (size_t)(BK * 2);
    const size_t hA = (size_t)HALF * g.lda * 2, hB = (size_t)HALF * g.ldb * 2, tA = 2 * hA, tB = 2 * hB;
    const unsigned ldsw = (unsigned)wid * 1024u;
    const int aoff = lds_byte(wr * 64 + fr, fq * 8), boff = lds_byte(wc * 32 + fr, fq * 8);
#define PG8_SA(b, h) (((b) * 2 + (h)) * HTB)
#define PG8_SB(b, h) ((4 + (b) * 2 + (h)) * HTB)
#define PG8_STAGE(bufoff, gbase, voff) do { _Pragma("unroll") for (int _i = 0; _i < 2; ++_i) \
        __builtin_amdgcn_global_load_lds((const unsigned*)((const char*)(gbase) + (voff)[_i]), (LAS unsigned*)(lds + (bufoff) + ldsw + _i * 8192), 16, 0, 0); } while (0)
#define PG8_LDA(dst, b, h) do { _Pragma("unroll") for (int m = 0; m < 4; ++m) _Pragma("unroll") for (int k = 0; k < 2; ++k) dst[m][k] = *(const LAS bf16x8*)(lds + PG8_SA(b, h) + aoff + m * 2048 + k * 1024); } while (0)
#define PG8_LDB(dst, b, h) do { _Pragma("unroll") for (int n = 0; n < 2; ++n) _Pragma("unroll") for (int k = 0; k < 2; ++k) dst[n][k] = *(const LAS bf16x8*)(lds + PG8_SB(b, h) + boff + n * 2048 + k * 1024); } while (0)
#define PG8_MMA(ai, bj, At, Bt) do { __builtin_amdgcn_s_setprio(1); _Pragma("unroll") for (int m = 0; m < 4; ++m) _Pragma("unroll") for (int n = 0; n < 2; ++n) _Pragma("unroll") for (int k = 0; k < 2; ++k) \
        acc[ai][bj][m][n] = __builtin_amdgcn_mfma_f32_16x16x32_bf16(Bt[n][k], At[m][k], acc[ai][bj][m][n], 0, 0, 0); __builtin_amdgcn_s_setprio(0); } while (0)
#define PG8_WAIT_V(n) asm volatile("s_waitcnt vmcnt(" #n ")" ::: "memory")
#define PG8_WAIT_L(n) asm volatile("s_waitcnt lgkmcnt(" #n ")" ::: "memory")
#define PG8_BAR __builtin_amdgcn_s_barrier()
#define PG8_SCHED __builtin_amdgcn_sched_barrier(0)
#define PG8_ABASE(u) ((const char*)g.A + (size_t)((u).pm & ((1 << g.ash) - 1)) * tA + (size_t)((u).pm >> g.ash) * g.sA)
#define PG8_BBASE(u) ((const char*)g.Bt + (size_t)(u).pn * tB + (size_t)((u).pm >> g.ash) * g.sB)
    Unit cur, nxt; int ui = 0;
    if (!S.next(0, cur)) return;
    f32x4 acc[2][2][4][2];
#pragma unroll
    for (int a = 0; a < 2; ++a)
#pragma unroll
        for (int b = 0; b < 2; ++b)
#pragma unroll
            for (int m = 0; m < 4; ++m)
#pragma unroll
                for (int n = 0; n < 2; ++n) acc[a][b][m][n] = (f32x4){0.f, 0.f, 0.f, 0.f};
    bf16x8 At[4][2], B0[2][2], B1[2][2];
    const char* cA = PG8_ABASE(cur); const char* cB = PG8_BBASE(cur);
    if constexpr (SP2) {
        PG8_STAGE(PG8_SB(0, 0), cB, voffB); PG8_STAGE(PG8_SB(0, 1), cB + hB, voffB); PG8_STAGE(PG8_SA(0, 0), cA, voffA); PG8_STAGE(PG8_SA(0, 1), cA + hA, voffA);
        if (wr == 1) PG8_BAR;
        PG8_WAIT_V(2); PG8_BAR;
        PG8_STAGE(PG8_SB(1, 0), cB + kstep, voffB); PG8_STAGE(PG8_SA(1, 0), cA + kstep, voffA); PG8_STAGE(PG8_SB(1, 1), cB + hB + kstep, voffB);
        PG8_WAIT_V(6); PG8_BAR;
    } else {
        PG8_STAGE(PG8_SB(0, 0), cB, voffB); PG8_STAGE(PG8_SA(0, 0), cA, voffA); PG8_STAGE(PG8_SB(0, 1), cB + hB, voffB); PG8_STAGE(PG8_SA(0, 1), cA + hA, voffA);
        if (wr == 1) PG8_BAR;
        PG8_WAIT_V(4); PG8_BAR;
        PG8_STAGE(PG8_SB(1, 0), cB + kstep, voffB); PG8_STAGE(PG8_SA(1, 0), cA + kstep, voffA); PG8_STAGE(PG8_SB(1, 1), cB + hB + kstep, voffB);
        PG8_WAIT_V(6); PG8_BAR;
    }
    for (;;) {
        const bool has_next = S.next(ui + 1, nxt);
        const char* nA = has_next ? PG8_ABASE(nxt) : cA; const char* nB = has_next ? PG8_BBASE(nxt) : cB;
        for (int t = 0; t < nt; t += 2) {
            const bool last = (t == nt - 2);
            const char* a1 = cA + (size_t)(t + 1) * kstep;
            const char* a2 = last ? nA : cA + (size_t)(t + 2) * kstep; const char* b2 = last ? nB : cB + (size_t)(t + 2) * kstep;
            const char* a3 = a2 + kstep; const char* b3 = b2 + kstep;
            if constexpr (SP2) {
            PG8_LDB(B0, 0, 0); PG8_LDB(B1, 0, 1); PG8_SCHED; PG8_LDA(At, 0, 0); PG8_STAGE(PG8_SA(1, 1), a1 + hA, voffA);
            PG8_WAIT_V(8); PG8_WAIT_L(0); PG8_BAR; PG8_MMA(0, 0, At, B0); PG8_MMA(0, 1, At, B1); PG8_BAR; PG8_SCHED;
            PG8_LDA(At, 0, 1); PG8_STAGE(PG8_SB(0, 0), b2, voffB); PG8_STAGE(PG8_SB(0, 1), b2 + hB, voffB); PG8_STAGE(PG8_SA(0, 0), a2, voffA);
            PG8_WAIT_V(8); PG8_WAIT_L(0); PG8_BAR; PG8_MMA(1, 0, At, B0); PG8_MMA(1, 1, At, B1); PG8_BAR; PG8_SCHED;
            PG8_LDB(B0, 1, 0); PG8_LDB(B1, 1, 1); PG8_SCHED; PG8_LDA(At, 1, 0); PG8_STAGE(PG8_SA(0, 1), a2 + hA, voffA);
            PG8_WAIT_V(8); PG8_WAIT_L(0); PG8_BAR; PG8_MMA(0, 0, At, B0); PG8_MMA(0, 1, At, B1); PG8_BAR; PG8_SCHED;
            PG8_LDA(At, 1, 1); PG8_STAGE(PG8_SB(1, 0), b3, voffB); PG8_STAGE(PG8_SB(1, 1), b3 + hB, voffB); PG8_STAGE(PG8_SA(1, 0), a3, voffA);
            PG8_WAIT_V(8); PG8_WAIT_L(0); PG8_BAR; PG8_MMA(1, 0, At, B0); PG8_MMA(1, 1, At, B1); PG8_BAR; PG8_SCHED;
            } else {
            PG8_LDB(B0, 0, 0); PG8_SCHED; PG8_LDA(At, 0, 0); PG8_STAGE(PG8_SA(1, 1), a1 + hA, voffA);
            PG8_WAIT_L(8); PG8_BAR; PG8_WAIT_L(0); PG8_MMA(0, 0, At, B0); PG8_BAR; PG8_SCHED;
            PG8_LDB(B1, 0, 1); PG8_STAGE(PG8_SB(0, 0), b2, voffB);
            PG8_BAR; PG8_WAIT_L(0); PG8_MMA(0, 1, At, B1); PG8_BAR;
            PG8_LDA(At, 0, 1); PG8_STAGE(PG8_SA(0, 0), a2, voffA);
            PG8_BAR; PG8_WAIT_L(0); PG8_MMA(1, 0, At, B0); PG8_BAR; PG8_SCHED;
            PG8_STAGE(PG8_SB(0, 1), b2 + hB, voffB);
            PG8_WAIT_V(6); PG8_BAR; PG8_MMA(1, 1, At, B1); PG8_BAR;
            PG8_LDB(B0, 1, 0); PG8_SCHED; PG8_LDA(At, 1, 0); PG8_STAGE(PG8_SA(0, 1), a2 + hA, voffA);
            PG8_WAIT_L(8); PG8_BAR; PG8_WAIT_L(0); PG8_MMA(0, 0, At, B0); PG8_BAR; PG8_SCHED;
            PG8_LDB(B1, 1, 1); PG8_STAGE(PG8_SB(1, 0), b3, voffB);
            PG8_BAR; PG8_WAIT_L(0); PG8_MMA(0, 1, At, B1); PG8_BAR;
            PG8_LDA(At, 1, 1); PG8_STAGE(PG8_SA(1, 0), a3, voffA);
            PG8_BAR; PG8_WAIT_L(0); PG8_MMA(1, 0, At, B0); PG8_BAR; PG8_SCHED;
            PG8_STAGE(PG8_SB(1, 1), b3 + hB, voffB);
            PG8_WAIT_V(6); PG8_BAR; PG8_MMA(1, 1, At, B1); PG8_BAR;
            }
        }
        if constexpr (ALIGN_EPI) { if (wr == 0) PG8_BAR; }
        E(acc, cur, wr, wc, fr, fq);
        if (!has_next) break;
#pragma unroll
        for (int a = 0; a < 2; ++a)
#pragma unroll
            for (int b = 0; b < 2; ++b)
#pragma unroll
                for (int m = 0; m < 4; ++m)
#pragma unroll
                    for (int n = 0; n < 2; ++n) acc[a][b][m][n] = (f32x4){0.f, 0.f, 0.f, 0.f};
        cur = nxt; cA = nA; cB = nB; ++ui;
        if constexpr (ALIGN_EPI) { if (wr == 1) PG8_BAR; }
    }
    PG8_WAIT_V(0);
    if constexpr (!ALIGN_EPI) { if (wr == 0) PG8_BAR; }
    PG8_BAR;
#undef PG8_SA
#undef PG8_SB
#undef PG8_STAGE
#undef PG8_LDA
#undef PG8_LDB
#undef PG8_MMA
#undef PG8_WAIT_V
#undef PG8_WAIT_L
#undef PG8_BAR
#undef PG8_SCHED
#undef PG8_ABASE
#undef PG8_BBASE
}
}

namespace att {
constexpr int AD = 128, NW = 8, QBLK = 32, KVBLK = 64;
constexpr float SCALE = 0.088388347648318440f;
constexpr float THR = 8.f;
constexpr int LDQ = NQKV, LDK = NQKV, LDO = D;
constexpr size_t SHM_V = KVBLK * AD * 2, SHM_K = KVBLK * AD * 2, SHM_ATTN = 2 * SHM_V + 2 * SHM_K + NW * 64 * 4;
#define KSWZ(row, colB) ((row) * 256 + ((colB) ^ (((row) & 7) << 4)))
#define SBAR() __builtin_amdgcn_sched_barrier(0)
__device__ __forceinline__ int crow(int r, int hi) { return (r & 3) + 8 * (r >> 2) + 4 * hi; }
__device__ __forceinline__ unsigned cvtpk(float lo, float hi) { unsigned r; asm volatile("v_cvt_pk_bf16_f32 %0, %1, %2" : "=v"(r) : "v"(lo), "v"(hi)); return r; }
__device__ __forceinline__ void partialSM(f32x16& p0, f32x16& p1, float& m_reg, float& mn, float& alpha) {
  constexpr float C = SCALE * 1.4426950408889634f;
  float pmax = p0[0]; for (int r = 1; r < 16; ++r) pmax = fmaxf(pmax, p0[r]); for (int r = 0; r < 16; ++r) pmax = fmaxf(pmax, p1[r]);
  { auto rr = __builtin_amdgcn_permlane32_swap(__float_as_uint(pmax), __float_as_uint(pmax), false, false);
    pmax = fmaxf(__uint_as_float(rr[0]), __uint_as_float(rr[1])); }
  if (__builtin_expect(__all(pmax - m_reg <= THR / SCALE), 1)) { mn = m_reg; alpha = 1.f; }
  else { mn = fmaxf(m_reg, pmax); alpha = __builtin_amdgcn_exp2f((m_reg - mn) * C); m_reg = mn; }
  float mnC = -mn * C;
  for (int r = 0; r < 16; ++r) p0[r] = fmaf(p0[r], C, mnC); for (int r = 0; r < 16; ++r) p1[r] = fmaf(p1[r], C, mnC);
  for (int r = 0; r < 16; ++r) p0[r] = __builtin_amdgcn_exp2f(p0[r]);
}
__device__ __forceinline__ void finishSM(f32x16& p0, f32x16& p1, float alpha, float& l_reg, bf16x8& pa0, bf16x8& pa1, bf16x8& pa2, bf16x8& pa3) {
  for (int r = 0; r < 16; ++r) p1[r] = __builtin_amdgcn_exp2f(p1[r]);
  float ps = 0; for (int r = 0; r < 16; ++r) ps += p0[r]; for (int r = 0; r < 16; ++r) ps += p1[r];
  { auto rr = __builtin_amdgcn_permlane32_swap(__float_as_uint(ps), __float_as_uint(ps), false, false);
    ps = __uint_as_float(rr[0]) + __uint_as_float(rr[1]); }
  l_reg = l_reg * alpha + ps;
#define PK4(P, BASE, OUT) do { unsigned a0 = cvtpk(P[BASE + 0], P[BASE + 1]), a1 = cvtpk(P[BASE + 2], P[BASE + 3]);   \
    unsigned b0 = cvtpk(P[BASE + 4], P[BASE + 5]), b1 = cvtpk(P[BASE + 6], P[BASE + 7]);                              \
    auto r0 = __builtin_amdgcn_permlane32_swap(a0, b0, false, false); auto r1 = __builtin_amdgcn_permlane32_swap(a1, b1, false, false); \
    u32x4 w = {r0[0], r1[0], r0[1], r1[1]}; OUT = *reinterpret_cast<bf16x8*>(&w); } while (0)
  PK4(p0, 0, pa0); PK4(p0, 8, pa1); PK4(p1, 0, pa2); PK4(p1, 8, pa3);
#undef PK4
}
__device__ __forceinline__ void qkt(f32x16& p0, f32x16& p1, const bf16_t* Ks, const bf16x8* qr, int r32, int hi) {
  p0 = f32x16{}; p1 = f32x16{};
  for (int d0 = 0; d0 < 8; ++d0) { int cb = (d0 * 16 + hi * 8) * 2;
    bf16x8 b0 = *reinterpret_cast<const bf16x8*>((const char*)Ks + KSWZ(r32, cb));
    bf16x8 b1 = *reinterpret_cast<const bf16x8*>((const char*)Ks + KSWZ(32 + r32, cb));
    p0 = __builtin_amdgcn_mfma_f32_32x32x16_bf16(b0, qr[d0], p0, 0, 0, 0);
    p1 = __builtin_amdgcn_mfma_f32_32x32x16_bf16(b1, qr[d0], p1, 0, 0, 0); }
}
__device__ __forceinline__ int v_st(int k, int c) { const int kk = (k & ~0xC) | ((k & 4) << 1) | ((k & 8) >> 1); return ((kk >> 3) * 4 + (c >> 5)) * 512 + ((kk & 7) * 32 + (c & 31)) * 2; }
__device__ __forceinline__ int v_rd_base(int lane) { return ((lane & 3) << 3) | (((lane >> 2) & 3) << 6) | (((lane >> 4) & 1) << 5) | (((lane >> 5) & 1) << 8); }
constexpr int v_rd_off(int d0, int ks, int half) { return d0 * 512 + ks * 4096 + half * 2048; }
template <int OFF> __device__ __forceinline__ s16x4 tr_read(int vb) {
  s16x4 r; asm volatile("ds_read_b64_tr_b16 %0, %1 offset:%2" : "=&v"(r) : "v"(vb), "i"(OFF) : "memory"); return r;
}
template <int D0> __device__ __forceinline__ void pv_one(f32x16& od, int vb, bf16x8 pa0, bf16x8 pa1, bf16x8 pa2, bf16x8 pa3) {
  const s16x4 l0 = tr_read<v_rd_off(D0, 0, 0)>(vb), h0 = tr_read<v_rd_off(D0, 0, 1)>(vb), l1 = tr_read<v_rd_off(D0, 1, 0)>(vb), h1 = tr_read<v_rd_off(D0, 1, 1)>(vb);
  const s16x4 l2 = tr_read<v_rd_off(D0, 2, 0)>(vb), h2 = tr_read<v_rd_off(D0, 2, 1)>(vb), l3 = tr_read<v_rd_off(D0, 3, 0)>(vb), h3 = tr_read<v_rd_off(D0, 3, 1)>(vb);
  asm volatile("s_waitcnt lgkmcnt(0)" ::: "memory"); SBAR();
#define PK(L, H) (bf16x8){L[0], L[1], L[2], L[3], H[0], H[1], H[2], H[3]}
  od = __builtin_amdgcn_mfma_f32_32x32x16_bf16(pa0, PK(l0, h0), od, 0, 0, 0);
  od = __builtin_amdgcn_mfma_f32_32x32x16_bf16(pa1, PK(l1, h1), od, 0, 0, 0);
  od = __builtin_amdgcn_mfma_f32_32x32x16_bf16(pa2, PK(l2, h2), od, 0, 0, 0);
  od = __builtin_amdgcn_mfma_f32_32x32x16_bf16(pa3, PK(l3, h3), od, 0, 0, 0);
#undef PK
}
__device__ __forceinline__ void pv_d0(f32x16* o, int vb, bf16x8 pa0, bf16x8 pa1, bf16x8 pa2, bf16x8 pa3) {
  pv_one<0>(o[0], vb, pa0, pa1, pa2, pa3); pv_one<1>(o[1], vb, pa0, pa1, pa2, pa3); pv_one<2>(o[2], vb, pa0, pa1, pa2, pa3); pv_one<3>(o[3], vb, pa0, pa1, pa2, pa3);
}
__device__ __forceinline__ void attn_dense_body(const bf16_t* __restrict__ Qb, const bf16_t* __restrict__ Kh, const bf16_t* __restrict__ Vh,
                                                bf16_t* __restrict__ Ob, int seq, char* lds) {
  constexpr int SDEPTH = 2;
  const int tid = tid_opaque(), wid = tid >> 6, lane = tid & 63, r32 = lane & 31, hi = lane >> 5;
  bf16_t* V_lds = (bf16_t*)lds; bf16_t* K_lds = (bf16_t*)(lds + 2 * SHM_V);
  float* ws = (float*)(lds + 2 * SHM_V + 2 * SHM_K) + wid * 64; float* li_l = ws; float* al_l = ws + 32;
  float m_reg = -1e30f, l_reg = 0; f32x16 o[4] = {}; bf16x8 qr[8];
  const bf16_t* Qw = Qb + (long)(wid * QBLK + r32) * LDQ + hi * 8;
#pragma unroll
  for (int d0 = 0; d0 < 8; ++d0) qr[d0] = *reinterpret_cast<const bf16x8*>(Qw + d0 * 16);
  const int sr = tid >> 4, sc = (tid & 15) * 8, vst0 = v_st(sr, sc), vst1 = v_st(32 + sr, sc);
  const int vb0 = (int)(uintptr_t)V_lds + v_rd_base(lane);
  struct { bf16x8 vs0, vs1, ks0, ks1; } sr_[SDEPTH];
#define SLOAD(i, k0) do { sr_[i].vs0 = *reinterpret_cast<const bf16x8*>(&Vh[(long)((k0) + sr) * LDK + sc]); sr_[i].vs1 = *reinterpret_cast<const bf16x8*>(&Vh[(long)((k0) + 32 + sr) * LDK + sc]); \
    sr_[i].ks0 = *reinterpret_cast<const bf16x8*>(&Kh[(long)((k0) + sr) * LDK + sc]); sr_[i].ks1 = *reinterpret_cast<const bf16x8*>(&Kh[(long)((k0) + 32 + sr) * LDK + sc]); } while (0)
#define SWRITE(b, i) do { *(bf16x8*)((char*)V_lds + (b) * SHM_V + vst0) = sr_[i].vs0;          \
    *(bf16x8*)((char*)V_lds + (b) * SHM_V + vst1) = sr_[i].vs1; int kc = sc * 2;               \
    *(bf16x8*)((char*)K_lds + (b) * SHM_K + KSWZ(sr, kc)) = sr_[i].ks0;                       \
    *(bf16x8*)((char*)K_lds + (b) * SHM_K + KSWZ(32 + sr, kc)) = sr_[i].ks1; } while (0)
#define SWAIT() do { asm volatile("s_waitcnt vmcnt(4)" ::: "memory"); } while (0)
#define RESC(a) do { if (__any((a) < 1.f)) { if (hi == 0) al_l[r32] = (a); asm volatile("s_waitcnt lgkmcnt(0)" ::: "memory"); \
    for (int d = 0; d < 4; ++d) for (int r = 0; r < 16; ++r) o[d][r] *= al_l[crow(r, hi)]; } } while (0)
  f32x16 pA0, pA1, pB0, pB1; float mnA, mnB, alA, alB; bf16x8 pa0, pa1, pa2, pa3; const int NT = seq / KVBLK;
  constexpr int SE = 0, SO = SDEPTH - 1;
  SLOAD(SE, 0); asm volatile("s_waitcnt vmcnt(0)" ::: "memory"); SWRITE(0, SE); __syncthreads();
  qkt(pA0, pA1, K_lds, qr, r32, hi); partialSM(pA0, pA1, m_reg, mnA, alA);
  SLOAD(SO, KVBLK); if (2 < NT) SLOAD(SE, 2 * KVBLK);
  SWAIT(); SWRITE(1, SO); __syncthreads();
  for (int j = 1; j + 1 < NT; j += 2) {
    SBAR(); qkt(pB0, pB1, (bf16_t*)((char*)K_lds + SHM_K), qr, r32, hi);
    finishSM(pA0, pA1, alA, l_reg, pa0, pa1, pa2, pa3); SBAR();
    SLOAD(SO, (j + SDEPTH) * KVBLK); SBAR();
    pv_d0(o, vb0, pa0, pa1, pa2, pa3); partialSM(pB0, pB1, m_reg, mnB, alB);
    __syncthreads(); SWAIT(); SWRITE(0, SE);
    RESC(alB); __syncthreads();
    SBAR(); qkt(pA0, pA1, K_lds, qr, r32, hi);
    finishSM(pB0, pB1, alB, l_reg, pa0, pa1, pa2, pa3); SBAR();
    if (j + 3 < NT) SLOAD(SE, (j + 1 + SDEPTH) * KVBLK); SBAR();
    pv_d0(o, vb0 + (int)SHM_V, pa0, pa1, pa2, pa3); partialSM(pA0, pA1, m_reg, mnA, alA);
    __syncthreads(); SWAIT(); SWRITE(1, SO);
    RESC(alA); __syncthreads();
  }
  SBAR(); qkt(pB0, pB1, (bf16_t*)((char*)K_lds + SHM_K), qr, r32, hi);
  finishSM(pA0, pA1, alA, l_reg, pa0, pa1, pa2, pa3); SBAR();
  pv_d0(o, vb0, pa0, pa1, pa2, pa3); partialSM(pB0, pB1, m_reg, mnB, alB);
  __syncthreads(); RESC(alB);
  finishSM(pB0, pB1, alB, l_reg, pa0, pa1, pa2, pa3); SBAR();
  pv_d0(o, vb0 + (int)SHM_V, pa0, pa1, pa2, pa3);
  if (hi == 0) li_l[r32] = l_reg; asm volatile("s_waitcnt lgkmcnt(0)" ::: "memory");
  float rli[16];
#pragma unroll
  for (int r = 0; r < 16; ++r) rli[r] = __builtin_amdgcn_rcpf(li_l[crow(r, hi)]);
  bf16_t* Ow = Ob + (long)(wid * QBLK) * LDO;
#pragma unroll
  for (int r = 0; r < 16; ++r) { int orow = crow(r, hi);
    for (int d0 = 0; d0 < 4; ++d0) Ow[(long)orow * LDO + d0 * 32 + r32] = (bf16_t)f2bf(o[d0][r] * rli[r]); }
  asm volatile("s_waitcnt vmcnt(0) lgkmcnt(0)" ::: "memory");
  __syncthreads();
#undef SLOAD
#undef SWRITE
#undef SWAIT
#undef RESC
}
}

struct Params;
typedef const __attribute__((address_space(4))) Params& KPR;
struct Params {
    const float* x_prompt; const float* x_sample; const float* c_prompt; const float* c_sample;
    const float* norm1_g; const float* norm2_g; const float* w_ada; const float* b_ada;
    const float* fnet_w_o; const float* attn_w_qkv; const float* attn_q_g; const float* attn_k_g; const float* attn_w_o;
    const float* sgu_w_in; const float* sgu_ln_g; const float* sgu_ln_b; const float* sgu_w_s; const float* sgu_b_s; const float* sgu_w_o;
    const float* ffn_w_gu; const float* ffn_w_down; const float* final_g;
    float* out; unsigned char* ws;
    int ph_lo, ph_hi;
};

enum { K_PREP = 0, K_NORM, K_CHANDFT, K_SEQDFT, K_RESID, K_GU, K_QKV, K_QKROPE, K_ATTN, K_WIN, K_SGU, K_FINAL };
struct PhaseDesc { unsigned char kind, layer, aux; };
constexpr int NPH = 31;
__device__ const PhaseDesc PHASES[NPH] = {
    {K_PREP, 0, 0},
    {K_NORM, 0, 0}, {K_CHANDFT, 0, 0}, {K_SEQDFT, 0, 0}, {K_RESID, 0, 0}, {K_NORM, 0, 1}, {K_GU, 0, 0}, {K_RESID, 0, 4},
    {K_NORM, 1, 0}, {K_QKV, 1, 0}, {K_QKROPE, 1, 0}, {K_ATTN, 1, 0}, {K_RESID, 1, 2}, {K_NORM, 1, 1}, {K_GU, 1, 0}, {K_RESID, 1, 4},
    {K_NORM, 2, 0}, {K_WIN, 2, 0}, {K_SGU, 2, 0}, {K_RESID, 2, 3}, {K_NORM, 2, 1}, {K_GU, 2, 0}, {K_RESID, 2, 4},
    {K_NORM, 3, 0}, {K_CHANDFT, 3, 0}, {K_SEQDFT, 3, 0}, {K_RESID, 3, 1}, {K_NORM, 3, 1}, {K_GU, 3, 0}, {K_RESID, 3, 4},
    {K_FINAL, 0, 0}};

__device__ __forceinline__ void transpose_item(const float* W, int K, int N, bf16_t* WT, int gu, LAS float* scr, int item, int lane) {
    const int nblk = N / 32, kb = item / nblk, nb = item % nblk, k0 = 64 * kb, n0 = 32 * nb;
#pragma unroll 8
    for (int i = 0; i < 32; ++i) { const int kk = 2 * i + (lane >> 5); scr[kk * 33 + (lane & 31)] = W[(size_t)(k0 + kk) * N + n0 + (lane & 31)]; }
    LDS_WAIT(); asm volatile("" ::: "memory");
    int d0 = n0;
    if (gu) { const int half = n0 / FF, j = n0 - half * FF; d0 = 256 * (j / 128) + 128 * half + (j % 128); }
    const int c = lane & 7;
#pragma unroll
    for (int j = 0; j < 4; ++j) { const int n = (lane >> 3) + 8 * j; const LAS float* s = scr + (8 * c) * 33 + n;
        u32x4 o; o.x = pk2(s[0 * 33], s[1 * 33]); o.y = pk2(s[2 * 33], s[3 * 33]); o.z = pk2(s[4 * 33], s[5 * 33]); o.w = pk2(s[6 * 33], s[7 * 33]);
        *(u32x4*)(WT + (size_t)(d0 + n) * K + k0 + 8 * c) = o; }
    LDS_WAIT(); asm volatile("" ::: "memory");
}

__device__ __forceinline__ void phase_prep(KPR p, LAS unsigned char* lds, int G) {
    const int tid = tid_opaque(), lane = tid & 63, wave = tid >> 6;
    unsigned char* ws = p.ws;
    for (int item = blockIdx.x; item < 4 * 48; item += G) {
        const int layer = item / 48, col0 = (item % 48) * 128;
        LAS float* csT = (LAS float*)lds;
        for (int idx = tid; idx < 32 * 1024; idx += NTHR) { const int b = idx >> 10, k = idx & 1023;
            const float c = b < 16 ? p.c_prompt[b * 1024 + k] : p.c_sample[(b - 16) * 1024 + k];
            csT[k * 32 + b] = c / (1.0f + __expf(-c)); }
        __syncthreads();
        float acc[32][2];
#pragma unroll
        for (int b = 0; b < 32; ++b) { acc[b][0] = 0.f; acc[b][1] = 0.f; }
        const float* wp = p.w_ada + ((size_t)layer * 1024 + wave * 128) * NMOD + col0 + 2 * lane;
#pragma unroll 4
        for (int kk = 0; kk < 128; ++kk) { const f32x2 wv = *(const f32x2*)(wp + (size_t)kk * NMOD); const LAS float* cr = csT + (wave * 128 + kk) * 32;
#pragma unroll
            for (int b = 0; b < 32; ++b) { const float cv = cr[b]; acc[b][0] += cv * wv.x; acc[b][1] += cv * wv.y; } }
        __syncthreads();
        LAS float* part = (LAS float*)lds;
#pragma unroll
        for (int b = 0; b < 32; ++b) *(LAS f32x2*)(part + (wave * 32 + b) * 128 + 2 * lane) = (f32x2){acc[b][0], acc[b][1]};
        __syncthreads();
        for (int o = tid; o < 32 * 128; o += NTHR) { const int b = o >> 7, cc = o & 127; float s = p.b_ada[layer * NMOD + col0 + cc];
#pragma unroll
            for (int w = 0; w < 8; ++w) s += part[(w * 32 + b) * 128 + cc];
            ((float*)(ws + WS_MOD))[((size_t)layer * 32 + b) * NMOD + col0 + cc] = s; }
        __syncthreads();
    }
    __syncthreads();
    {
        LAS float* scr = (LAS float*)(lds + wave * 16384);
        const int gw = blockIdx.x * NWAVES + wave, NGW = G * NWAVES;
        constexpr int I_SQ = (D / 64) * (D / 32), I_QKV = (D / 64) * (NQKV / 32), I_WIN = (D / 64) * (2048 / 32), I_GU = (D / 64) * (2 * FF / 32), I_DN = (FF / 64) * (D / 32);
        constexpr int NITEMS = 4 * I_SQ + I_QKV + I_WIN + 4 * I_GU + 4 * I_DN;
        for (int it = gw; it < NITEMS; it += NGW) {
            int r = it;
            if (r < 2 * I_SQ) { const int j = r / I_SQ; transpose_item(p.fnet_w_o + (size_t)j * D * D, D, D, (bf16_t*)(ws + WS_FNETW) + (size_t)j * D * D, 0, scr, r % I_SQ, lane); continue; } r -= 2 * I_SQ;
            if (r < I_SQ) { transpose_item(p.attn_w_o, D, D, (bf16_t*)(ws + WS_WAO), 0, scr, r, lane); continue; } r -= I_SQ;
            if (r < I_SQ) { transpose_item(p.sgu_w_o, D, D, (bf16_t*)(ws + WS_WSO), 0, scr, r, lane); continue; } r -= I_SQ;
            if (r < I_QKV) { transpose_item(p.attn_w_qkv, D, NQKV, (bf16_t*)(ws + WS_WQKV), 0, scr, r, lane); continue; } r -= I_QKV;
            if (r < I_WIN) { transpose_item(p.sgu_w_in, D, 2048, (bf16_t*)(ws + WS_WIN), 0, scr, r, lane); continue; } r -= I_WIN;
            if (r < 4 * I_GU) { const int j = r / I_GU; transpose_item(p.ffn_w_gu + (size_t)j * D * 2 * FF, D, 2 * FF, (bf16_t*)(ws + WS_WGU) + (size_t)j * D * 2 * FF, 1, scr, r % I_GU, lane); continue; } r -= 4 * I_GU;
            { const int j = r / I_DN; transpose_item(p.ffn_w_down + (size_t)j * FF * D, FF, D, (bf16_t*)(ws + WS_WDN) + (size_t)j * FF * D, 0, scr, r % I_DN, lane); }
        }
    }
    const size_t gt = (size_t)blockIdx.x * NTHR + tid, NGT = (size_t)G * NTHR;
    for (size_t i = gt; i < 8 * 128 * 128; i += NGT) ((bf16_t*)(ws + WS_WSB))[i] = (bf16_t)f2bf(p.sgu_w_s[i]);
    for (size_t i = gt; i < 512 * 256; i += NGT) { const int m = (int)(i >> 8), c = (int)(i & 255), l = m & 255; const float a = (float)((l * c) & 255) * (1.0f / 128.0f);
        ((bf16_t*)(ws + WS_DFTC))[i] = (bf16_t)f2bf(m < 256 ? cospif(a) : sinpif(a)); }
    for (size_t i = gt; i < (size_t)4096 * 8192 / 8; i += NGT) { const int k = (int)(i >> 10), j0 = (int)(i & 1023) * 8; float v[8];
#pragma unroll
        for (int e = 0; e < 8; ++e) { const int j = j0 + e, jj = j & 4095; const float a = (float)((k * jj) & 4095) * (1.0f / 2048.0f); v[e] = j < 4096 ? cospif(a) : -sinpif(a); }
        u32x4 o; o.x = pk2(v[0], v[1]); o.y = pk2(v[2], v[3]); o.z = pk2(v[4], v[5]); o.w = pk2(v[6], v[7]);
        *(u32x4*)((bf16_t*)(ws + WS_SEQ4) + i * 8) = o; }
    for (size_t i = gt; i < (size_t)2048 * 4096 / 8; i += NGT) { const int k = (int)(i >> 9), j0 = (int)(i & 511) * 8; float v[8];
#pragma unroll
        for (int e = 0; e < 8; ++e) { const int j = j0 + e, jj = j & 2047; const float a = (float)((k * jj) & 2047) * (1.0f / 1024.0f); v[e] = j < 2048 ? cospif(a) : -sinpif(a); }
        u32x4 o; o.x = pk2(v[0], v[1]); o.y = pk2(v[2], v[3]); o.z = pk2(v[4], v[5]); o.w = pk2(v[6], v[7]);
        *(u32x4*)((bf16_t*)(ws + WS_SEQ2) + i * 8) = o; }
}

__device__ __forceinline__ void phase_norm(KPR p, int layer, int which, int G) {
    const int tid = tid_opaque(), lane = tid & 63, wave = tid >> 6;
    const bool first = (layer == 0 && which == 0);
    const float* gam = (which ? p.norm2_g : p.norm1_g) + layer * D;
    const float* mod = (const float*)(p.ws + WS_MOD) + (size_t)layer * 32 * NMOD + (which ? 3 : 0) * D;
    bf16_t* H = (bf16_t*)(p.ws + WS_H);
    f32x4 gv[4];
#pragma unroll
    for (int j = 0; j < 4; ++j) gv[j] = *(const f32x4*)(gam + 4 * (lane + 64 * j));
    for (int row = blockIdx.x * NWAVES + wave; row < T; row += G * NWAVES) {
        const float* xr = first ? (row < TP ? p.x_prompt + (size_t)row * D : p.x_sample + (size_t)(row - TP) * D) : p.out + (size_t)row * D;
        f32x4 v[4]; float s = 0.f;
#pragma unroll
        for (int j = 0; j < 4; ++j) { v[j] = *(const f32x4*)(xr + 4 * (lane + 64 * j)); s += (v[j].x * v[j].x + v[j].y * v[j].y) + (v[j].z * v[j].z + v[j].w * v[j].w); }
        const float rstd = rsqrtf(wave_sum(s) * (1.0f / D) + EPS);
        const float* mr = mod + (size_t)seq_of(row) * NMOD;
#pragma unroll
        for (int j = 0; j < 4; ++j) { const int c = 4 * (lane + 64 * j); const f32x4 sh = *(const f32x4*)(mr + c), sc = *(const f32x4*)(mr + D + c);
            const f32x4 y = (v[j] * rstd) * gv[j]; const f32x4 h = y * (sc + 1.0f) + sh;
            u32x2 w; w.x = pk2(h.x, h.y); w.y = pk2(h.z, h.w);
            *(u32x2*)(H + (size_t)row * D + c) = w; }
    }
}

__device__ __forceinline__ void phase_final(KPR p, int G) {
    const int tid = tid_opaque(), lane = tid & 63, wave = tid >> 6;
    f32x4 gv[4];
#pragma unroll
    for (int j = 0; j < 4; ++j) gv[j] = *(const f32x4*)(p.final_g + 4 * (lane + 64 * j));
    for (int row = blockIdx.x * NWAVES + wave; row < T; row += G * NWAVES) {
        float* xr = p.out + (size_t)row * D;
        f32x4 v[4]; float s = 0.f;
#pragma unroll
        for (int j = 0; j < 4; ++j) { v[j] = *(const f32x4*)(xr + 4 * (lane + 64 * j)); s += (v[j].x * v[j].x + v[j].y * v[j].y) + (v[j].z * v[j].z + v[j].w * v[j].w); }
        const float rstd = rsqrtf(wave_sum(s) * (1.0f / D) + EPS);
#pragma unroll
        for (int j = 0; j < 4; ++j) *(f32x4*)(xr + 4 * (lane + 64 * j)) = (v[j] * rstd) * gv[j];
    }
}

__device__ __forceinline__ void phase_qkrope(KPR p, int G) {
    const int tid = tid_opaque(), lane = tid & 63, wave = tid >> 6;
    bf16_t* QKVb = (bf16_t*)(p.ws + WS_BIG);
    const int i0 = 2 * (lane & 15);
    const float f0 = 1.0f / powf(10000.0f, (float)(2 * i0) / 64.0f), f1 = 1.0f / powf(10000.0f, (float)(2 * (i0 + 1)) / 64.0f);
    const bool x2 = (lane & 31) >= 16, colhalf = lane >= 32;
    const f32x2 qg = *(const f32x2*)(p.attn_q_g + 2 * lane), kg = *(const f32x2*)(p.attn_k_g + 2 * lane);
    for (int row = blockIdx.x * NWAVES + wave; row < T; row += G * NWAVES) {
        const int sq = seq_of(row), t = row - seq_start(sq);
        const float pos = (float)(colhalf ? (t & 63) : (t >> 6));
        float s0, c0, s1, c1; sincosf(pos * f0, &s0, &c0); sincosf(pos * f1, &s1, &c1);
        unsigned* rp = (unsigned*)(QKVb + (size_t)row * NQKV) + lane;
        unsigned raw[10];
#pragma unroll
        for (int h = 0; h < 10; ++h) raw[h] = rp[h * 64];
#pragma unroll
        for (int h = 0; h < 10; ++h) {
            const float v0 = bf2f((unsigned short)(raw[h] & 0xffffu)), v1 = bf2f((unsigned short)(raw[h] >> 16));
            const float rstd = rsqrtf(wave_sum(v0 * v0 + v1 * v1) * (1.0f / 128.0f) + EPS);
            const f32x2 g = h < 8 ? qg : kg;
            const float y0 = v0 * rstd * g.x, y1 = v1 * rstd * g.y;
            const float z0 = __shfl_xor(y0, 16), z1 = __shfl_xor(y1, 16);
            const float o0 = x2 ? (y0 * c0 + z0 * s0) : (y0 * c0 - z0 * s0);
            const float o1 = x2 ? (y1 * c1 + z1 * s1) : (y1 * c1 - z1 * s1);
            rp[h * 64] = pk2(o0, o1);
        }
    }
}

__device__ __forceinline__ void phase_attn(KPR p, char* lds, int G) {
    const bf16_t* QKVb = (const bf16_t*)(p.ws + WS_BIG); bf16_t* O = (bf16_t*)(p.ws + WS_H);
    const int bx = blockIdx.x, vcu = (G % 8 == 0) ? (bx % 8) * (G / 8) + bx / 8 : bx;
    for (int u = vcu; u < 2048 + 1024; u += G) {
        int b, kvh, g, qb, S;
        if (u < 2048) { b = u >> 7; const int r = u & 127; kvh = r >> 6; g = (r >> 4) & 3; qb = r & 15; S = SP; }
        else { const int v = u - 2048; b = 16 + (v >> 6); const int r = v & 63; kvh = r >> 5; g = (r >> 3) & 3; qb = r & 7; S = SS; }
        const int h = kvh * 4 + g; const size_t r0 = (size_t)seq_start(b);
        att::attn_dense_body(QKVb + (r0 + (size_t)qb * 256) * NQKV + h * 128, QKVb + r0 * NQKV + 1024 + kvh * 128, QKVb + r0 * NQKV + 1280 + kvh * 128,
                             O + (r0 + (size_t)qb * 256) * D + h * 128, S, lds);
    }
}

__device__ __forceinline__ void phase_sgu(KPR p, char* lds, int G) {
    const int tid = tid_opaque(), lane = tid & 63, wave = tid >> 6, r32 = lane & 31, hi = lane >> 5;
    const bf16_t* UV = (const bf16_t*)(p.ws + WS_BIG); bf16_t* OUT = (bf16_t*)(p.ws + WS_H); const bf16_t* WSB = (const bf16_t*)(p.ws + WS_WSB);
    constexpr int VS = 136;
    bf16_t* VT = (bf16_t*)lds;
    float* st = (float*)(lds + 128 * VS * 2);
    for (int ci = blockIdx.x; ci < T / 128; ci += G) {
        const size_t r0 = (size_t)ci * 128;
        for (int rr = 0; rr < 16; ++rr) { const int j = wave * 16 + rr; const bf16_t* vp = UV + (r0 + j) * 2048 + 1024 + 8 * lane;
            const bf16x8 a = *(const bf16x8*)vp, b = *(const bf16x8*)(vp + 512); float x[16]; float s = 0.f;
#pragma unroll
            for (int e = 0; e < 8; ++e) { x[e] = bf2f((unsigned short)a[e]); x[8 + e] = bf2f((unsigned short)b[e]); }
#pragma unroll
            for (int e = 0; e < 16; ++e) s += x[e];
            const float mean = wave_sum(s) * (1.0f / 1024.0f); float q = 0.f;
#pragma unroll
            for (int e = 0; e < 16; ++e) { const float d = x[e] - mean; q += d * d; }
            const float rstd = rsqrtf(wave_sum(q) * (1.0f / 1024.0f) + EPS);
            if (lane == 0) { st[2 * j] = mean; st[2 * j + 1] = rstd; } }
        __syncthreads();
        for (int g = 0; g < 8; ++g) {
            { const int j = tid & 127; const float mean = st[2 * j], rstd = st[2 * j + 1];
#pragma unroll
              for (int it = 0; it < 4; ++it) { const int c0 = 8 * ((tid >> 7) + 4 * it);
                const bf16x8 a = *(const bf16x8*)(UV + (r0 + j) * 2048 + 1024 + g * 128 + c0);
#pragma unroll
                for (int e = 0; e < 8; ++e) { const int c = c0 + e; const float vn = (bf2f((unsigned short)a[e]) - mean) * rstd * p.sgu_ln_g[g * 128 + c] + p.sgu_ln_b[g * 128 + c];
                    VT[c * VS + j] = (bf16_t)f2bf(vn); } } }
            __syncthreads();
            const int it_ = wave >> 1, ct0 = (wave & 1) * 2;
            f32x16 acc0 = {}, acc1 = {};
            const bf16_t* ap = WSB + (size_t)g * 16384 + (32 * it_ + r32) * 128 + 8 * hi;
#pragma unroll
            for (int ks = 0; ks < 8; ++ks) {
                const bf16x8 af = *(const bf16x8*)(ap + 16 * ks);
                const bf16x8 b0 = *(const bf16x8*)(VT + (32 * ct0 + r32) * VS + 16 * ks + 8 * hi);
                const bf16x8 b1 = *(const bf16x8*)(VT + (32 * (ct0 + 1) + r32) * VS + 16 * ks + 8 * hi);
                acc0 = __builtin_amdgcn_mfma_f32_32x32x16_bf16(af, b0, acc0, 0, 0, 0);
                acc1 = __builtin_amdgcn_mfma_f32_32x32x16_bf16(af, b1, acc1, 0, 0, 0);
            }
#pragma unroll
            for (int r = 0; r < 16; ++r) { const int i = 32 * it_ + att::crow(r, hi); const float bs = p.sgu_b_s[g * 128 + i];
                const size_t ro = r0 + i; const int c_0 = g * 128 + 32 * ct0 + r32, c_1 = c_0 + 32;
                const float u0 = bf2f(UV[ro * 2048 + c_0]), u1 = bf2f(UV[ro * 2048 + c_1]);
                OUT[ro * D + c_0] = (bf16_t)f2bf(u0 * (acc0[r] + bs)); OUT[ro * D + c_1] = (bf16_t)f2bf(u1 * (acc1[r] + bs)); }
            __syncthreads();
        }
    }
}

__global__ void __launch_bounds__(NTHR, 2) mega_fwd(Params p_arg) {
    extern __shared__ __attribute__((aligned(16))) unsigned char lds[];
    LAS unsigned char* ldsl = (LAS unsigned char*)lds;
    const int G = gridDim.x;
    const __attribute__((address_space(4))) Params* kp = (const __attribute__((address_space(4))) Params*)__builtin_amdgcn_kernarg_segment_ptr();
    const int ph_lo = kp->ph_lo, ph_hi = kp->ph_hi;
    for (int ph = ph_lo; ph < ph_hi; ++ph) {
        asm volatile("" : "+s"(kp));
        KPR p = *kp;
        unsigned char* ws = p.ws;
        const PhaseDesc pd = PHASES[ph];
        const int layer = pd.layer;
        switch (pd.kind) {
        case K_PREP: if (EN(K_PREP)) phase_prep(p, ldsl, G); break;
        case K_NORM: if (EN(K_NORM)) phase_norm(p, layer, pd.aux, G); break;
        case K_FINAL: if (EN(K_FINAL)) phase_final(p, G); break;
        case K_QKROPE: if (EN(K_QKROPE)) phase_qkrope(p, G); break;
        case K_ATTN: if (EN(K_ATTN)) phase_attn(p, (char*)lds, G); break;
        case K_SGU: if (EN(K_SGU)) phase_sgu(p, (char*)lds, G); break;
        case K_CHANDFT: if (EN(K_CHANDFT)) {
            pg8::Gemm g{(const bf16_t*)(ws + WS_DFTC), (const bf16_t*)(ws + WS_H), 256, D, 256, 1, 0, (size_t)256 * 2};
            pg8::StaticOrder S; S.init(8, T / 256, G, blockIdx.x);
            pg8::EpiChanDft E{(bf16_t*)(ws + WS_BIG)};
            pg8::gemm_phase<pg8::EpiChanDft, pg8::StaticOrder, true, true>(ldsl, g, S, E);
        } break;
        case K_SEQDFT: if (EN(K_SEQDFT)) {
            for (int part = 0; part < 2; ++part) {
                const int S_ = part ? SS : SP;
                pg8::Gemm g{(const bf16_t*)(ws + (part ? WS_SEQ2 : WS_SEQ4)), (const bf16_t*)(ws + WS_BIG) + (part ? (size_t)16 * 1024 * 8192 : 0), 2 * S_, 2 * S_, 2 * S_, part ? 3 : 4, 0, (size_t)1024 * 2 * S_ * 2};
                pg8::StaticOrder S; S.init((part ? TS : TP) / 256, 4, G, blockIdx.x);
                pg8::EpiBf16<0> E{(bf16_t*)(ws + WS_H) + (part ? (size_t)TP * D : 0), D, part ? 0.022097086912079608f : 0.015625f};
                pg8::gemm_phase<pg8::EpiBf16<0>, pg8::StaticOrder, true, true>(ldsl, g, S, E);
            }
        } break;
        case K_QKV: if (EN(K_QKV)) {
            pg8::Gemm g{(const bf16_t*)(ws + WS_H), (const bf16_t*)(ws + WS_WQKV), D, D, D, 30, 0, 0};
            pg8::StaticOrder S; S.init(T / 256, NQKV / 256, G, blockIdx.x);
            pg8::EpiBf16<0> E{(bf16_t*)(ws + WS_BIG), NQKV, 1.0f};
            pg8::gemm_phase<pg8::EpiBf16<0>, pg8::StaticOrder, true, true>(ldsl, g, S, E);
        } break;
        case K_WIN: if (EN(K_WIN)) {
            pg8::Gemm g{(const bf16_t*)(ws + WS_H), (const bf16_t*)(ws + WS_WIN), D, D, D, 30, 0, 0};
            pg8::StaticOrder S; S.init(T / 256, 2048 / 256, G, blockIdx.x);
            pg8::EpiBf16<1> E{(bf16_t*)(ws + WS_BIG), 2048, 1.0f};
            pg8::gemm_phase<pg8::EpiBf16<1>, pg8::StaticOrder, true, true>(ldsl, g, S, E);
        } break;
        case K_GU: if (EN(K_GU)) {
            pg8::Gemm g{(const bf16_t*)(ws + WS_H), (const bf16_t*)(ws + WS_WGU) + (size_t)layer * D * 2 * FF, D, D, D, 30, 0, 0};
            pg8::StaticOrder S; S.init(T / 256, 2 * FF / 256, G, blockIdx.x);
            pg8::EpiSwiGlu E{(bf16_t*)(ws + WS_BIG)};
            pg8::gemm_phase<pg8::EpiSwiGlu, pg8::StaticOrder, true, true>(ldsl, g, S, E);
        } break;
        case K_RESID: if (EN(K_RESID)) {
            const int aux = pd.aux; const bool first = (layer == 0 && aux != 4);
            const bf16_t* A = (const bf16_t*)(ws + (aux == 4 ? WS_BIG : WS_H));
            const bf16_t* W = aux == 0 ? (const bf16_t*)(ws + WS_FNETW) : aux == 1 ? (const bf16_t*)(ws + WS_FNETW) + (size_t)D * D : aux == 2 ? (const bf16_t*)(ws + WS_WAO)
                            : aux == 3 ? (const bf16_t*)(ws + WS_WSO) : (const bf16_t*)(ws + WS_WDN) + (size_t)layer * FF * D;
            const int K = aux == 4 ? FF : D;
            pg8::Gemm g{A, W, K, K, K, 30, 0, 0};
            pg8::StaticOrder S; S.init(T / 256, D / 256, G, blockIdx.x);
            pg8::EpiResid E{first ? p.x_prompt : p.out, first ? p.x_sample - (size_t)TP * D : p.out, p.out,
                            (const float*)(ws + WS_MOD) + (size_t)layer * 32 * NMOD + (aux == 4 ? 5 : 2) * D};
            pg8::gemm_phase<pg8::EpiResid, pg8::StaticOrder, true, true>(ldsl, g, S, E);
        } break;
        }
        if (ph + 1 < ph_hi) { __threadfence(); cg::this_grid().sync(); }
    }
}

extern "C" void kernel_launch(void* const* d_in, const int* in_sizes, int n_in, void* d_out, int out_size, void* d_ws, size_t ws_size, hipStream_t stream) {
    static int grid = 0;
    if (grid == 0) {
        if (n_in != 22 || in_sizes[0] != TP * D || in_sizes[1] != TS * D || out_size != T * D || ws_size < WS_END) {
            fprintf(stderr, "kernel_launch: shape mismatch n_in %d in0 %d in1 %d out %d ws %zu (need %zu)\n", n_in, n_in > 0 ? in_sizes[0] : -1, n_in > 1 ? in_sizes[1] : -1, out_size, ws_size, (size_t)WS_END);
            grid = -1; return; }
        int dev = 0, cus = 0, per_cu = 0;
        if (hipGetDevice(&dev) != hipSuccess || hipDeviceGetAttribute(&cus, hipDeviceAttributeMultiprocessorCount, dev) != hipSuccess) { grid = -1; return; }
        if (hipFuncSetAttribute((const void*)mega_fwd, hipFuncAttributeMaxDynamicSharedMemorySize, LDS_BYTES) != hipSuccess) { fprintf(stderr, "kernel_launch: hipFuncSetAttribute failed\n"); grid = -1; return; }
        if (hipOccupancyMaxActiveBlocksPerMultiprocessor(&per_cu, (const void*)mega_fwd, NTHR, LDS_BYTES) != hipSuccess || per_cu < 1) { fprintf(stderr, "kernel_launch: occupancy query gave %d\n", per_cu); per_cu = 1; }
        (void)hipGetLastError();
        grid = cus * per_cu;
        fprintf(stderr, "kernel_launch: grid %d (cus %d x %d)\n", grid, cus, per_cu);
    }
    if (grid < 0) return;
    Params p{};
    p.x_prompt = (const float*)d_in[0]; p.x_sample = (const float*)d_in[1]; p.c_prompt = (const float*)d_in[2]; p.c_sample = (const float*)d_in[3];
    p.norm1_g = (const float*)d_in[4]; p.norm2_g = (const float*)d_in[5]; p.w_ada = (const float*)d_in[6]; p.b_ada = (const float*)d_in[7];
    p.fnet_w_o = (const float*)d_in[8]; p.attn_w_qkv = (const float*)d_in[9]; p.attn_q_g = (const float*)d_in[10]; p.attn_k_g = (const float*)d_in[11]; p.attn_w_o = (const float*)d_in[12];
    p.sgu_w_in = (const float*)d_in[13]; p.sgu_ln_g = (const float*)d_in[14]; p.sgu_ln_b = (const float*)d_in[15]; p.sgu_w_s = (const float*)d_in[16]; p.sgu_b_s = (const float*)d_in[17]; p.sgu_w_o = (const float*)d_in[18];
    p.ffn_w_gu = (const float*)d_in[19]; p.ffn_w_down = (const float*)d_in[20]; p.final_g = (const float*)d_in[21];
    p.out = (float*)d_out; p.ws = (unsigned char*)d_ws;
#if MK_SINGLE
    p.ph_lo = 0; p.ph_hi = NPH;
    void* args[] = {&p};
    hipError_t e = hipLaunchCooperativeKernel((const void*)mega_fwd, dim3(grid), dim3(NTHR), args, LDS_BYTES, stream);
    if (e != hipSuccess) fprintf(stderr, "kernel_launch: cooperative launch failed: %s (grid %d)\n", hipGetErrorString(e), grid);
#else
    for (int ph = 0; ph < NPH; ++ph) {
        p.ph_lo = ph; p.ph_hi = ph + 1;
        hipLaunchKernelGGL(mega_fwd, dim3(grid), dim3(NTHR), LDS_BYTES, stream, p);
    }
    const hipError_t le = hipPeekAtLastError();
    if (le != hipSuccess) fprintf(stderr, "kernel_launch: launch failed: %s\n", hipGetErrorName(le));
#endif
}
```

```cpp
#include <hip/hip_runtime.h>
#include <hip/hip_cooperative_groups.h>
#include <cstdio>
#include <cstdint>
namespace cg = cooperative_groups;

#ifndef MK_EN
#define MK_EN 0xFFF
#endif
#define EN(k) (((MK_EN) >> (k)) & 1)
#ifndef MK_SINGLE
#define MK_SINGLE 1
#endif

#define LAS __attribute__((address_space(3)))
typedef unsigned short bf16_t;
typedef short bf16x8 __attribute__((ext_vector_type(8)));
typedef short s16x4 __attribute__((ext_vector_type(4)));
typedef float f32x2 __attribute__((ext_vector_type(2)));
typedef float f32x4 __attribute__((ext_vector_type(4)));
typedef float f32x16 __attribute__((ext_vector_type(16)));
typedef unsigned u32x2 __attribute__((ext_vector_type(2)));
typedef unsigned u32x4 __attribute__((ext_vector_type(4)));

constexpr int D = 1024, TP = 65536, TS = 32768, T = TP + TS, SP = 4096, SS = 2048, FF = 2816, NQKV = 1536, NMOD = 6144;
constexpr float EPS = 1e-6f;
constexpr int NWAVES = 8, NTHR = 512;
constexpr int LDS_BYTES = 147456;

__device__ __forceinline__ int seq_of(int row) { return row < TP ? (row >> 12) : 16 + ((row - TP) >> 11); }
__device__ __forceinline__ int seq_start(int s) { return s < 16 ? (s << 12) : TP + ((s - 16) << 11); }
__device__ __forceinline__ int seq_len(int s) { return s < 16 ? SP : SS; }
__device__ __forceinline__ size_t zt_base(int s) { return s < 16 ? (size_t)s * (1024u * 8192u) : (size_t)16 * (1024u * 8192u) + (size_t)(s - 16) * (1024u * 4096u); }

constexpr size_t MiB = 1u << 20;
constexpr size_t WS_MOD = 0;
constexpr size_t WS_DFTC = 3 * MiB;
constexpr size_t WS_WSB = WS_DFTC + 256 * 1024;
constexpr size_t WS_BAR = WS_WSB + 256 * 1024, BAR_BYTES = 16384;
constexpr size_t WS_FNETW = 4 * MiB;
constexpr size_t WS_WQKV = 8 * MiB;
constexpr size_t WS_WAO = 11 * MiB;
constexpr size_t WS_WIN = 13 * MiB;
constexpr size_t WS_WSO = 17 * MiB;
constexpr size_t WS_WGU = 19 * MiB;
constexpr size_t WS_WDN = 63 * MiB;
constexpr size_t WS_SEQ4 = 85 * MiB;
constexpr size_t WS_SEQ2 = 149 * MiB;
constexpr size_t WS_H = 165 * MiB;
constexpr size_t WS_BIG = 357 * MiB;
constexpr size_t WS_END = 885 * MiB;

__device__ __forceinline__ unsigned f2bf(float f) { unsigned u = __builtin_bit_cast(unsigned, f); return (u + 0x7fffu + ((u >> 16) & 1u)) >> 16; }
__device__ __forceinline__ unsigned pk2(float lo, float hi) { return f2bf(lo) | (f2bf(hi) << 16); }
__device__ __forceinline__ float bf2f(unsigned short b) { return __builtin_bit_cast(float, ((unsigned)b) << 16); }
__device__ __forceinline__ unsigned cvt_pk_bf16(float lo, float hi) { unsigned r; asm volatile("v_cvt_pk_bf16_f32 %0, %1, %2" : "=v"(r) : "v"(lo), "v"(hi)); return r; }
__device__ __forceinline__ float wave_sum(float v) {
#pragma unroll
    for (int o = 1; o < 64; o <<= 1) v += __shfl_xor(v, o);
    return v;
}
__device__ __forceinline__ int tid_opaque() { int t = threadIdx.x; asm volatile("" : "+v"(t)); return t; }
#define LDS_WAIT() asm volatile("s_waitcnt lgkmcnt(0)" ::: "memory")

namespace pg8 {
constexpr int BM = 256, BK = 64, HALF = 128, HTB = HALF * BK * 2, STAGE_BYTES = 8 * HTB, NXCD = 8, WGM = 8;
__host__ __device__ __forceinline__ int lds_byte(int r, int c) { const int st = (r >> 4) * 2 + (c >> 5), rr = r & 15, cc = c & 31, ob = rr * 64 + cc * 2; return st * 1024 + (ob ^ (((ob >> 9) & 1) << 5)); }
__host__ __device__ __forceinline__ void stage_rc(int b, int& R, int& C) { const int st = b / 1024, sb = b % 1024, swz = sb ^ (((sb >> 9) & 1) << 5); R = (st >> 1) * 16 + swz / 64; C = (st & 1) * 32 + (swz % 64) / 2; }
__host__ __device__ __forceinline__ int perm32(int rho) { const int n = rho >> 4, i = rho & 15; return 8 * (i >> 2) + 4 * n + (i & 3); }

struct Unit { int pm, pn; };
struct Gemm { const bf16_t* A; const bf16_t* Bt; int lda, ldb, K, ash; size_t sA, sB; };

struct StaticOrder {
    int nM, nN, nwg, G, c;
    __device__ void init(int nM_, int nN_, int G_, int c_) { nM = nM_; nN = nN_; nwg = nM * nN; G = G_; c = c_; }
    __device__ bool next(int i, Unit& u) const {
        const long L = (long)i * G + c; if (L >= nwg) return false;
        int wgid = (int)L; { const int q = nwg / NXCD, r = nwg % NXCD, xcd = wgid % NXCD, off = wgid / NXCD; wgid = (xcd < r ? xcd * (q + 1) : r * (q + 1) + (xcd - r) * q) + off; }
        const int nig = WGM * nN, gid = wgid / nig, fm = gid * WGM, gsz = (nM - fm) < WGM ? (nM - fm) : WGM;
        u.pm = fm + ((wgid % nig) % gsz); u.pn = (wgid % nig) / gsz; return true;
    }
};

__device__ __forceinline__ f32x2 gelu_pk(f32x2 v) {
    const f32x2 av = __builtin_elementwise_abs(v), d = av * 0.2316418882f + 1.0f;
    f32x2 t; t.x = __builtin_amdgcn_rcpf(d.x); t.y = __builtin_amdgcn_rcpf(d.y);
    f32x2 q = t * 0.5307027145f + (-0.7265760135f); q = q * t + 0.7107068705f; q = q * t + (-0.142248368f); q = q * t + 0.127414796f; q = q * t;
    const f32x2 s = (v * v) * (-0.72134752044f);
    f32x2 e; e.x = __builtin_amdgcn_exp2f(s.x); e.y = __builtin_amdgcn_exp2f(s.y);
    const f32x2 m = v * (q * e), r = v - m;
    f32x2 o; o.x = v.x < 0.f ? m.x : r.x; o.y = v.y < 0.f ? m.y : r.y; return o;
}

template <int ACT> struct EpiBf16 {
    static constexpr bool PERM = true;
    bf16_t* O; int ldc; float scale;
    __device__ __forceinline__ void operator()(const f32x4 (&acc)[2][2][4][2], const Unit& u, int wr, int wc, int fr, int fq) const {
        const unsigned row0 = u.pm * BM + wr * 64 + fr, col0 = u.pn * BM + wc * 32 + 8 * fq;
        char* Ob = (char*)O;
#pragma unroll
        for (int ai = 0; ai < 2; ++ai)
#pragma unroll
            for (int m = 0; m < 4; ++m) { const unsigned ob = ((row0 + ai * HALF + m * 16) * (unsigned)ldc + col0) * 2u;
#pragma unroll
                for (int bj = 0; bj < 2; ++bj) { f32x4 v0 = acc[ai][bj][m][0], v1 = acc[ai][bj][m][1];
                    if (ACT == 1) { f32x2 a = gelu_pk((f32x2){v0[0], v0[1]}), b = gelu_pk((f32x2){v0[2], v0[3]}), c = gelu_pk((f32x2){v1[0], v1[1]}), d = gelu_pk((f32x2){v1[2], v1[3]});
                        v0 = (f32x4){a.x, a.y, b.x, b.y}; v1 = (f32x4){c.x, c.y, d.x, d.y}; }
                    v0 = v0 * scale; v1 = v1 * scale;
                    u32x4 w; w.x = cvt_pk_bf16(v0[0], v0[1]); w.y = cvt_pk_bf16(v0[2], v0[3]); w.z = cvt_pk_bf16(v1[0], v1[1]); w.w = cvt_pk_bf16(v1[2], v1[3]);
                    *(u32x4*)(Ob + (size_t)(ob + bj * HALF * 2)) = w; } }
    }
};
struct EpiChanDft {
    static constexpr bool PERM = true;
    bf16_t* Zt;
    __device__ __forceinline__ void operator()(const f32x4 (&acc)[2][2][4][2], const Unit& u, int wr, int wc, int fr, int fq) const {
        const int g = u.pm >> 1, cs = u.pm & 1, t0 = u.pn * BM, sq = seq_of(t0), S = seq_len(sq), s0 = t0 - seq_start(sq);
        const unsigned rs = 4u * (unsigned)S;
        char* lp = (char*)(Zt + zt_base(sq) + (size_t)cs * S + s0) + (size_t)((unsigned)(g * 256 + wr * 64 + fr) * rs + (unsigned)(wc * 32 + 8 * fq) * 2u);
#pragma unroll
        for (int ai = 0; ai < 2; ++ai)
#pragma unroll
            for (int m = 0; m < 4; ++m) { char* rp = lp + (size_t)((unsigned)(ai * HALF + m * 16) * rs);
#pragma unroll
                for (int bj = 0; bj < 2; ++bj) { const f32x4 v0 = acc[ai][bj][m][0] * 0.0625f, v1 = acc[ai][bj][m][1] * 0.0625f;
                    u32x4 w; w.x = cvt_pk_bf16(v0[0], v0[1]); w.y = cvt_pk_bf16(v0[2], v0[3]); w.z = cvt_pk_bf16(v1[0], v1[1]); w.w = cvt_pk_bf16(v1[2], v1[3]);
                    *(u32x4*)(rp + bj * HALF * 2) = w; }
                asm volatile("" ::: "memory"); }
    }
};
struct EpiSwiGlu {
    static constexpr bool PERM = true;
    bf16_t* Hd;
    __device__ __forceinline__ void operator()(const f32x4 (&acc)[2][2][4][2], const Unit& u, int wr, int wc, int fr, int fq) const {
        const unsigned row0 = u.pm * BM + wr * 64 + fr, col0 = u.pn * HALF + wc * 32 + 8 * fq;
        char* Hb = (char*)Hd;
#pragma unroll
        for (int ai = 0; ai < 2; ++ai)
#pragma unroll
            for (int m = 0; m < 4; ++m) { const unsigned ob = ((row0 + ai * HALF + m * 16) * (unsigned)FF + col0) * 2u;
                float o[8];
#pragma unroll
                for (int n = 0; n < 2; ++n)
#pragma unroll
                    for (int e = 0; e < 4; ++e) { const float gv = acc[ai][0][m][n][e], uv = acc[ai][1][m][n][e];
                        const float sg = gv * __builtin_amdgcn_rcpf(1.0f + __builtin_amdgcn_exp2f(-1.4426950408889634f * gv)); o[n * 4 + e] = sg * uv; }
                u32x4 w; w.x = cvt_pk_bf16(o[0], o[1]); w.y = cvt_pk_bf16(o[2], o[3]); w.z = cvt_pk_bf16(o[4], o[5]); w.w = cvt_pk_bf16(o[6], o[7]);
                *(u32x4*)(Hb + (size_t)ob) = w; }
    }
};
struct EpiResid {
    static constexpr bool PERM = false;
    const float* srcP; const float* srcS;
    float* out; const float* gate;
    __device__ __forceinline__ void operator()(const f32x4 (&acc)[2][2][4][2], const Unit& u, int wr, int wc, int fr, int fq) const {
        const unsigned row0 = u.pm * BM + wr * 64 + fr, col0 = u.pn * BM + wc * 32 + 4 * fq;
        const int sq = seq_of(u.pm * BM); const float* gp = gate + (size_t)sq * NMOD; const char* sb = (const char*)((u.pm * BM < TP) ? srcP : srcS); char* ob_ = (char*)out;
        f32x4 gv[2][2];
#pragma unroll
        for (int bj = 0; bj < 2; ++bj)
#pragma unroll
            for (int n = 0; n < 2; ++n) gv[bj][n] = *(const f32x4*)(gp + col0 + bj * HALF + n * 16);
#pragma unroll
        for (int ai = 0; ai < 2; ++ai)
#pragma unroll
            for (int m = 0; m < 4; ++m) { const unsigned off = ((row0 + ai * HALF + m * 16) * (unsigned)D + col0) * 4u;
#pragma unroll
                for (int bj = 0; bj < 2; ++bj)
#pragma unroll
                    for (int n = 0; n < 2; ++n) { const unsigned o2 = off + (bj * HALF + n * 16) * 4; const f32x4 xs = *(const f32x4*)(sb + (size_t)o2);
                        *(f32x4*)(ob_ + (size_t)o2) = xs + gv[bj][n] * acc[ai][bj][m][n]; }
                asm volatile("" ::: "memory"); }
    }
};

template <class Epi, class Sched, bool ALIGN_EPI, bool SP2>
__device__ __forceinline__ void gemm_phase(LAS unsigned char* lds, const Gemm g, const Sched& S, const Epi& E) {
    const int tid = tid_opaque(), wid = __builtin_amdgcn_readfirstlane(tid >> 6), lane = tid & 63, wr = wid >> 2, wc = wid & 3, fr = lane & 15, fq = lane >> 4;
    int K = g.K; asm volatile("" : "+s"(K));
    const int nt = K / BK;
    unsigned voffA[2], voffB[2];
#pragma unroll
    for (int i = 0; i < 2; ++i) { int R, C; stage_rc(tid * 16 + i * 8192, R, C); const int Rb = Epi::PERM ? ((R & ~31) + perm32(R & 31)) : R;
        voffA[i] = (unsigned)(R * g.lda + C) * 2u; voffB[i] = (unsigned)(Rb * g.ldb + C) * 2u; }
    const size_t kstep = (size_t)(BK * 2);
    const size_t hA = (size_t)HALF * g.lda * 2, hB = (size_t)HALF * g.ldb * 2, tA = 2 * hA, tB = 2 * hB;
    const unsigned ldsw = (unsigned)wid * 1024u;
    const int aoff = lds_byte(wr * 64 + fr, fq * 8), boff = lds_byte(wc * 32 + fr, fq * 8);
#define PG8_SA(b, h) (((b) * 2 + (h)) * HTB)
#define PG8_SB(b, h) ((4 + (b) * 2 + (h)) * HTB)
#define PG8_STAGE(bufoff, gbase, voff) do { _Pragma("unroll") for (int _i = 0; _i < 2; ++_i) \
        __builtin_amdgcn_global_load_lds((const unsigned*)((const char*)(gbase) + (voff)[_i]), (LAS unsigned*)(lds + (bufoff) + ldsw + _i * 8192), 16, 0, 0); } while (0)
#define PG8_LDA(dst, b, h) do { _Pragma("unroll") for (int m = 0; m < 4; ++m) _Pragma("unroll") for (int k = 0; k < 2; ++k) dst[m][k] = *(const LAS bf16x8*)(lds + PG8_SA(b, h) + aoff + m * 2048 + k * 1024); } while (0)
#define PG8_LDB(dst, b, h) do { _Pragma("unroll") for (int n = 0; n < 2; ++n) _Pragma("unroll") for (int k = 0; k < 2; ++k) dst[n][k] = *(const LAS bf16x8*)(lds + PG8_SB(b, h) + boff + n * 2048 + k * 1024); } while (0)
#define PG8_MMA(ai, bj, At, Bt) do { __builtin_amdgcn_s_setprio(1); _Pragma("unroll") for (int m = 0; m < 4; ++m) _Pragma("unroll") for (int n = 0; n < 2; ++n) _Pragma("unroll") for (int k = 0; k < 2; ++k) \
        acc[ai][bj][m][n] = __builtin_amdgcn_mfma_f32_16x16x32_bf16(Bt[n][k], At[m][k], acc[ai][bj][m][n], 0, 0, 0); __builtin_amdgcn_s_setprio(0); } while (0)
#define PG8_WAIT_V(n) asm volatile("s_waitcnt vmcnt(" #n ")" ::: "memory")
#define PG8_WAIT_L(n) asm volatile("s_waitcnt lgkmcnt(" #n ")" ::: "memory")
#define PG8_BAR __builtin_amdgcn_s_barrier()
#define PG8_SCHED __builtin_amdgcn_sched_barrier(0)
#define PG8_ABASE(u) ((const char*)g.A + (size_t)((u).pm & ((1 << g.ash) - 1)) * tA + (size_t)((u).pm >> g.ash) * g.sA)
#define PG8_BBASE(u) ((const char*)g.Bt + (size_t)(u).pn * tB + (size_t)((u).pm >> g.ash) * g.sB)
    Unit cur, nxt; int ui = 0;
    if (!S.next(0, cur)) return;
    f32x4 acc[2][2][4][2];
#pragma unroll
    for (int a = 0; a < 2; ++a)
#pragma unroll
        for (int b = 0; b < 2; ++b)
#pragma unroll
            for (int m = 0; m < 4; ++m)
#pragma unroll
                for (int n = 0; n < 2; ++n) acc[a][b][m][n] = (f32x4){0.f, 0.f, 0.f, 0.f};
    bf16x8 At[4][2], B0[2][2], B1[2][2];
    const char* cA = PG8_ABASE(cur); const char* cB = PG8_BBASE(cur);
    if constexpr (SP2) {
        PG8_STAGE(PG8_SB(0, 0), cB, voffB); PG8_STAGE(PG8_SB(0, 1), cB + hB, voffB); PG8_STAGE(PG8_SA(0, 0), cA, voffA); PG8_STAGE(PG8_SA(0, 1), cA + hA, voffA);
        if (wr == 1) PG8_BAR;
        PG8_WAIT_V(2); PG8_BAR;
        PG8_STAGE(PG8_SB(1, 0), cB + kstep, voffB); PG8_STAGE(PG8_SA(1, 0), cA + kstep, voffA); PG8_STAGE(PG8_SB(1, 1), cB + hB + kstep, voffB);
        PG8_WAIT_V(6); PG8_BAR;
    } else {
        PG8_STAGE(PG8_SB(0, 0), cB, voffB); PG8_STAGE(PG8_SA(0, 0), cA, voffA); PG8_STAGE(PG8_SB(0, 1), cB + hB, voffB); PG8_STAGE(PG8_SA(0, 1), cA + hA, voffA);
        if (wr == 1) PG8_BAR;
        PG8_WAIT_V(4); PG8_BAR;
        PG8_STAGE(PG8_SB(1, 0), cB + kstep, voffB); PG8_STAGE(PG8_SA(1, 0), cA + kstep, voffA); PG8_STAGE(PG8_SB(1, 1), cB + hB + kstep, voffB);
        PG8_WAIT_V(6); PG8_BAR;
    }
    for (;;) {
        const bool has_next = S.next(ui + 1, nxt);
        const char* nA = has_next ? PG8_ABASE(nxt) : cA; const char* nB = has_next ? PG8_BBASE(nxt) : cB;
        for (int t = 0; t < nt; t += 2) {
            const bool last = (t == nt - 2);
            const char* a1 = cA + (size_t)(t + 1) * kstep;
            const char* a2 = last ? nA : cA + (size_t)(t + 2) * kstep; const char* b2 = last ? nB : cB + (size_t)(t + 2) * kstep;
            const char* a3 = a2 + kstep; const char* b3 = b2 + kstep;
            if constexpr (SP2) {
            PG8_LDB(B0, 0, 0); PG8_LDB(B1, 0, 1); PG8_SCHED; PG8_LDA(At, 0, 0); PG8_STAGE(PG8_SA(1, 1), a1 + hA, voffA);
            PG8_WAIT_V(8); PG8_WAIT_L(0); PG8_BAR; PG8_MMA(0, 0, At, B0); PG8_MMA(0, 1, At, B1); PG8_BAR; PG8_SCHED;
            PG8_LDA(At, 0, 1); PG8_STAGE(PG8_SB(0, 0), b2, voffB); PG8_STAGE(PG8_SB(0, 1), b2 + hB, voffB); PG8_STAGE(PG8_SA(0, 0), a2, voffA);
            PG8_WAIT_V(8); PG8_WAIT_L(0); PG8_BAR; PG8_MMA(1, 0, At, B0); PG8_MMA(1, 1, At, B1); PG8_BAR; PG8_SCHED;
            PG8_LDB(B0, 1, 0); PG8_LDB(B1, 1, 1); PG8_SCHED; PG8_LDA(At, 1, 0); PG8_STAGE(PG8_SA(0, 1), a2 + hA, voffA);
            PG8_WAIT_V(8); PG8_WAIT_L(0); PG8_BAR; PG8_MMA(0, 0, At, B0); PG8_MMA(0, 1, At, B1); PG8_BAR; PG8_SCHED;
            PG8_LDA(At, 1, 1); PG8_STAGE(PG8_SB(1, 0), b3, voffB); PG8_STAGE(PG8_SB(1, 1), b3 + hB, voffB); PG8_STAGE(PG8_SA(1, 0), a3, voffA);
            PG8_WAIT_V(8); PG8_WAIT_L(0); PG8_BAR; PG8_MMA(1, 0, At, B0); PG8_MMA(1, 1, At, B1); PG8_BAR; PG8_SCHED;
            } else {
            PG8_LDB(B0, 0, 0); PG8_SCHED; PG8_LDA(At, 0, 0); PG8_STAGE(PG8_SA(1, 1), a1 + hA, voffA);
            PG8_WAIT_L(8); PG8_BAR; PG8_WAIT_L(0); PG8_MMA(0, 0, At, B0); PG8_BAR; PG8_SCHED;
            PG8_LDB(B1, 0, 1); PG8_STAGE(PG8_SB(0, 0), b2, voffB);
            PG8_BAR; PG8_WAIT_L(0); PG8_MMA(0, 1, At, B1); PG8_BAR;
            PG8_LDA(At, 0, 1); PG8_STAGE(PG8_SA(0, 0), a2, voffA);
            PG8_BAR; PG8_WAIT_L(0); PG8_MMA(1, 0, At, B0); PG8_BAR; PG8_SCHED;
            PG8_STAGE(PG8_SB(0, 1), b2 + hB, voffB);
            PG8_WAIT_V(6); PG8_BAR; PG8_MMA(1, 1, At, B1); PG8_BAR;
            PG8_LDB(B0, 1, 0); PG8_SCHED; PG8_LDA(At, 1, 0); PG8_STAGE(PG8_SA(0, 1), a2 + hA, voffA);
            PG8_WAIT_L(8); PG8_BAR; PG8_WAIT_L(0); PG8_MMA(0, 0, At, B0); PG8_BAR; PG8_SCHED;
            PG8_LDB(B1, 1, 1); PG8_STAGE(PG8_SB(1, 0), b3, voffB);
            PG8_BAR; PG8_WAIT_L(0); PG8_MMA(0, 1, At, B1); PG8_BAR;
            PG8_LDA(At, 1, 1); PG8_STAGE(PG8_SA(1, 0), a3, voffA);
            PG8_BAR; PG8_WAIT_L(0); PG8_MMA(1, 0, At, B0); PG8_BAR; PG8_SCHED;
            PG8_STAGE(PG8_SB(1, 1), b3 + hB, voffB);
            PG8_WAIT_V(6); PG8_BAR; PG8_MMA(1, 1, At, B1); PG8_BAR;
            }
        }
        if constexpr (ALIGN_EPI) { if (wr == 0) PG8_BAR; }
        E(acc, cur, wr, wc, fr, fq);
        if (!has_next) break;
#pragma unroll
        for (int a = 0; a < 2; ++a)
#pragma unroll
            for (int b = 0; b < 2; ++b)
#pragma unroll
                for (int m = 0; m < 4; ++m)
#pragma unroll
                    for (int n = 0; n < 2; ++n) acc[a][b][m][n] = (f32x4){0.f, 0.f, 0.f, 0.f};
        cur = nxt; cA = nA; cB = nB; ++ui;
        if constexpr (ALIGN_EPI) { if (wr == 1) PG8_BAR; }
    }
    PG8_WAIT_V(0);
    if constexpr (!ALIGN_EPI) { if (wr == 0) PG8_BAR; }
    PG8_BAR;
#undef PG8_SA
#undef PG8_SB
#undef PG8_STAGE
#undef PG8_LDA
#undef PG8_LDB
#undef PG8_MMA
#undef PG8_WAIT_V
#undef PG8_WAIT_L
#undef PG8_BAR
#undef PG8_SCHED
#undef PG8_ABASE
#undef PG8_BBASE
}
}

namespace att {
constexpr int AD = 128, NW = 8, QBLK = 32, KVBLK = 64;
constexpr float SCALE = 0.088388347648318440f;
constexpr float THR = 8.f;
constexpr int LDQ = NQKV, LDK = NQKV, LDO = D;
constexpr size_t SHM_V = KVBLK * AD * 2, SHM_K = KVBLK * AD * 2, SHM_ATTN = 2 * SHM_V + 2 * SHM_K + NW * 64 * 4;
#define KSWZ(row, colB) ((row) * 256 + ((colB) ^ (((row) & 7) << 4)))
#define SBAR() __builtin_amdgcn_sched_barrier(0)
__device__ __forceinline__ int crow(int r, int hi) { return (r & 3) + 8 * (r >> 2) + 4 * hi; }
__device__ __forceinline__ unsigned cvtpk(float lo, float hi) { unsigned r; asm volatile("v_cvt_pk_bf16_f32 %0, %1, %2" : "=v"(r) : "v"(lo), "v"(hi)); return r; }
__device__ __forceinline__ void partialSM(f32x16& p0, f32x16& p1, float& m_reg, float& mn, float& alpha) {
  constexpr float C = SCALE * 1.4426950408889634f;
  float pmax = p0[0]; for (int r = 1; r < 16; ++r) pmax = fmaxf(pmax, p0[r]); for (int r = 0; r < 16; ++r) pmax = fmaxf(pmax, p1[r]);
  { auto rr = __builtin_amdgcn_permlane32_swap(__float_as_uint(pmax), __float_as_uint(pmax), false, false);
    pmax = fmaxf(__uint_as_float(rr[0]), __uint_as_float(rr[1])); }
  if (__builtin_expect(__all(pmax - m_reg <= THR / SCALE), 1)) { mn = m_reg; alpha = 1.f; }
  else { mn = fmaxf(m_reg, pmax); alpha = __builtin_amdgcn_exp2f((m_reg - mn) * C); m_reg = mn; }
  float mnC = -mn * C;
  for (int r = 0; r < 16; ++r) p0[r] = fmaf(p0[r], C, mnC); for (int r = 0; r < 16; ++r) p1[r] = fmaf(p1[r], C, mnC);
  for (int r = 0; r < 16; ++r) p0[r] = __builtin_amdgcn_exp2f(p0[r]);
}
__device__ __forceinline__ void finishSM(f32x16& p0, f32x16& p1, float alpha, float& l_reg, bf16x8& pa0, bf16x8& pa1, bf16x8& pa2, bf16x8& pa3) {
  for (int r = 0; r < 16; ++r) p1[r] = __builtin_amdgcn_exp2f(p1[r]);
  float ps = 0; for (int r = 0; r < 16; ++r) ps += p0[r]; for (int r = 0; r < 16; ++r) ps += p1[r];
  { auto rr = __builtin_amdgcn_permlane32_swap(__float_as_uint(ps), __float_as_uint(ps), false, false);
    ps = __uint_as_float(rr[0]) + __uint_as_float(rr[1]); }
  l_reg = l_reg * alpha + ps;
#define PK4(P, BASE, OUT) do { unsigned a0 = cvtpk(P[BASE + 0], P[BASE + 1]), a1 = cvtpk(P[BASE + 2], P[BASE + 3]);   \
    unsigned b0 = cvtpk(P[BASE + 4], P[BASE + 5]), b1 = cvtpk(P[BASE + 6], P[BASE + 7]);                              \
    auto r0 = __builtin_amdgcn_permlane32_swap(a0, b0, false, false); auto r1 = __builtin_amdgcn_permlane32_swap(a1, b1, false, false); \
    u32x4 w = {r0[0], r1[0], r0[1], r1[1]}; OUT = *reinterpret_cast<bf16x8*>(&w); } while (0)
  PK4(p0, 0, pa0); PK4(p0, 8, pa1); PK4(p1, 0, pa2); PK4(p1, 8, pa3);
#undef PK4
}
__device__ __forceinline__ void qkt(f32x16& p0, f32x16& p1, const bf16_t* Ks, const bf16x8* qr, int r32, int hi) {
  p0 = f32x16{}; p1 = f32x16{};
  for (int d0 = 0; d0 < 8; ++d0) { int cb = (d0 * 16 + hi * 8) * 2;
    bf16x8 b0 = *reinterpret_cast<const bf16x8*>((const char*)Ks + KSWZ(r32, cb));
    bf16x8 b1 = *reinterpret_cast<const bf16x8*>((const char*)Ks + KSWZ(32 + r32, cb));
    p0 = __builtin_amdgcn_mfma_f32_32x32x16_bf16(b0, qr[d0], p0, 0, 0, 0);
    p1 = __builtin_amdgcn_mfma_f32_32x32x16_bf16(b1, qr[d0], p1, 0, 0, 0); }
}
__device__ __forceinline__ int v_st(int k, int c) { const int kk = (k & ~0xC) | ((k & 4) << 1) | ((k & 8) >> 1); return ((kk >> 3) * 4 + (c >> 5)) * 512 + ((kk & 7) * 32 + (c & 31)) * 2; }
__device__ __forceinline__ int v_rd_base(int lane) { return ((lane & 3) << 3) | (((lane >> 2) & 3) << 6) | (((lane >> 4) & 1) << 5) | (((lane >> 5) & 1) << 8); }
constexpr int v_rd_off(int d0, int ks, int half) { return d0 * 512 + ks * 4096 + half * 2048; }
template <int OFF> __device__ __forceinline__ s16x4 tr_read(int vb) {
  s16x4 r; asm volatile("ds_read_b64_tr_b16 %0, %1 offset:%2" : "=&v"(r) : "v"(vb), "i"(OFF) : "memory"); return r;
}
template <int D0> __device__ __forceinline__ void pv_one(f32x16& od, int vb, bf16x8 pa0, bf16x8 pa1, bf16x8 pa2, bf16x8 pa3) {
  const s16x4 l0 = tr_read<v_rd_off(D0, 0, 0)>(vb), h0 = tr_read<v_rd_off(D0, 0, 1)>(vb), l1 = tr_read<v_rd_off(D0, 1, 0)>(vb), h1 = tr_read<v_rd_off(D0, 1, 1)>(vb);
  const s16x4 l2 = tr_read<v_rd_off(D0, 2, 0)>(vb), h2 = tr_read<v_rd_off(D0, 2, 1)>(vb), l3 = tr_read<v_rd_off(D0, 3, 0)>(vb), h3 = tr_read<v_rd_off(D0, 3, 1)>(vb);
  asm volatile("s_waitcnt lgkmcnt(0)" ::: "memory"); SBAR();
#define PK(L, H) (bf16x8){L[0], L[1], L[2], L[3], H[0], H[1], H[2], H[3]}
  od = __builtin_amdgcn_mfma_f32_32x32x16_bf16(pa0, PK(l0, h0), od, 0, 0, 0);
  od = __builtin_amdgcn_mfma_f32_32x32x16_bf16(pa1, PK(l1, h1), od, 0, 0, 0);
  od = __builtin_amdgcn_mfma_f32_32x32x16_bf16(pa2, PK(l2, h2), od, 0, 0, 0);
  od = __builtin_amdgcn_mfma_f32_32x32x16_bf16(pa3, PK(l3, h3), od, 0, 0, 0);
#undef PK
}
__device__ __forceinline__ void pv_d0(f32x16* o, int vb, bf16x8 pa0, bf16x8 pa1, bf16x8 pa2, bf16x8 pa3) {
  pv_one<0>(o[0], vb, pa0, pa1, pa2, pa3); pv_one<1>(o[1], vb, pa0, pa1, pa2, pa3); pv_one<2>(o[2], vb, pa0, pa1, pa2, pa3); pv_one<3>(o[3], vb, pa0, pa1, pa2, pa3);
}
__device__ __forceinline__ void attn_dense_body(const bf16_t* __restrict__ Qb, const bf16_t* __restrict__ Kh, const bf16_t* __restrict__ Vh,
                                                bf16_t* __restrict__ Ob, int seq, char* lds) {
  constexpr int SDEPTH = 2;
  const int tid = tid_opaque(), wid = tid >> 6, lane = tid & 63, r32 = lane & 31, hi = lane >> 5;
  bf16_t* V_lds = (bf16_t*)lds; bf16_t* K_lds = (bf16_t*)(lds + 2 * SHM_V);
  float* ws = (float*)(lds + 2 * SHM_V + 2 * SHM_K) + wid * 64; float* li_l = ws; float* al_l = ws + 32;
  float m_reg = -1e30f, l_reg = 0; f32x16 o[4] = {}; bf16x8 qr[8];
  const bf16_t* Qw = Qb + (long)(wid * QBLK + r32) * LDQ + hi * 8;
#pragma unroll
  for (int d0 = 0; d0 < 8; ++d0) qr[d0] = *reinterpret_cast<const bf16x8*>(Qw + d0 * 16);
  const int sr = tid >> 4, sc = (tid & 15) * 8, vst0 = v_st(sr, sc), vst1 = v_st(32 + sr, sc);
  const int vb0 = (int)(uintptr_t)V_lds + v_rd_base(lane);
  struct { bf16x8 vs0, vs1, ks0, ks1; } sr_[SDEPTH];
#define SLOAD(i, k0) do { sr_[i].vs0 = *reinterpret_cast<const bf16x8*>(&Vh[(long)((k0) + sr) * LDK + sc]); sr_[i].vs1 = *reinterpret_cast<const bf16x8*>(&Vh[(long)((k0) + 32 + sr) * LDK + sc]); \
    sr_[i].ks0 = *reinterpret_cast<const bf16x8*>(&Kh[(long)((k0) + sr) * LDK + sc]); sr_[i].ks1 = *reinterpret_cast<const bf16x8*>(&Kh[(long)((k0) + 32 + sr) * LDK + sc]); } while (0)
#define SWRITE(b, i) do { *(bf16x8*)((char*)V_lds + (b) * SHM_V + vst0) = sr_[i].vs0;          \
    *(bf16x8*)((char*)V_lds + (b) * SHM_V + vst1) = sr_[i].vs1; int kc = sc * 2;               \
    *(bf16x8*)((char*)K_lds + (b) * SHM_K + KSWZ(sr, kc)) = sr_[i].ks0;                       \
    *(bf16x8*)((char*)K_lds + (b) * SHM_K + KSWZ(32 + sr, kc)) = sr_[i].ks1; } while (0)
#define SWAIT() do { asm volatile("s_waitcnt vmcnt(4)" ::: "memory"); } while (0)
#define RESC(a) do { if (__any((a) < 1.f)) { if (hi == 0) al_l[r32] = (a); asm volatile("s_waitcnt lgkmcnt(0)" ::: "memory"); \
    for (int d = 0; d < 4; ++d) for (int r = 0; r < 16; ++r) o[d][r] *= al_l[crow(r, hi)]; } } while (0)
  f32x16 pA0, pA1, pB0, pB1; float mnA, mnB, alA, alB; bf16x8 pa0, pa1, pa2, pa3; const int NT = seq / KVBLK;
  constexpr int SE = 0, SO = SDEPTH - 1;
  SLOAD(SE, 0); asm volatile("s_waitcnt vmcnt(0)" ::: "memory"); SWRITE(0, SE); __syncthreads();
  qkt(pA0, pA1, K_lds, qr, r32, hi); partialSM(pA0, pA1, m_reg, mnA, alA);
  SLOAD(SO, KVBLK); if (2 < NT) SLOAD(SE, 2 * KVBLK);
  SWAIT(); SWRITE(1, SO); __syncthreads();
  for (int j = 1; j + 1 < NT; j += 2) {
    SBAR(); qkt(pB0, pB1, (bf16_t*)((char*)K_lds + SHM_K), qr, r32, hi);
    finishSM(pA0, pA1, alA, l_reg, pa0, pa1, pa2, pa3); SBAR();
    SLOAD(SO, (j + SDEPTH) * KVBLK); SBAR();
    pv_d0(o, vb0, pa0, pa1, pa2, pa3); partialSM(pB0, pB1, m_reg, mnB, alB);
    __syncthreads(); SWAIT(); SWRITE(0, SE);
    RESC(alB); __syncthreads();
    SBAR(); qkt(pA0, pA1, K_lds, qr, r32, hi);
    finishSM(pB0, pB1, alB, l_reg, pa0, pa1, pa2, pa3); SBAR();
    if (j + 3 < NT) SLOAD(SE, (j + 1 + SDEPTH) * KVBLK); SBAR();
    pv_d0(o, vb0 + (int)SHM_V, pa0, pa1, pa2, pa3); partialSM(pA0, pA1, m_reg, mnA, alA);
    __syncthreads(); SWAIT(); SWRITE(1, SO);
    RESC(alA); __syncthreads();
  }
  SBAR(); qkt(pB0, pB1, (bf16_t*)((char*)K_lds + SHM_K), qr, r32, hi);
  finishSM(pA0, pA1, alA, l_reg, pa0, pa1, pa2, pa3); SBAR();
  pv_d0(o, vb0, pa0, pa1, pa2, pa3); partialSM(pB0, pB1, m_reg, mnB, alB);
  __syncthreads(); RESC(alB);
  finishSM(pB0, pB1, alB, l_reg, pa0, pa1, pa2, pa3); SBAR();
  pv_d0(o, vb0 + (int)SHM_V, pa0, pa1, pa2, pa3);
  if (hi == 0) li_l[r32] = l_reg; asm volatile("s_waitcnt lgkmcnt(0)" ::: "memory");
  float rli[16];
#pragma unroll
  for (int r = 0; r < 16; ++r) rli[r] = __builtin_amdgcn_rcpf(li_l[crow(r, hi)]);
  bf16_t* Ow = Ob + (long)(wid * QBLK) * LDO;
#pragma unroll
  for (int r = 0; r < 16; ++r) { int orow = crow(r, hi);
    for (int d0 = 0; d0 < 4; ++d0) Ow[(long)orow * LDO + d0 * 32 + r32] = (bf16_t)f2bf(o[d0][r] * rli[r]); }
  asm volatile("s_waitcnt vmcnt(0) lgkmcnt(0)" ::: "memory");
  __syncthreads();
#undef SLOAD
#undef SWRITE
#undef SWAIT
#undef RESC
}
}

struct Params;
typedef const __attribute__((address_space(4))) Params& KPR;
struct Params {
    const float* x_prompt; const float* x_sample; const float* c_prompt; const float* c_sample;
    const float* norm1_g; const float* norm2_g; const float* w_ada; const float* b_ada;
    const float* fnet_w_o; const float* attn_w_qkv; const float* attn_q_g; const float* attn_k_g; const float* attn_w_o;
    const float* sgu_w_in; const float* sgu_ln_g; const float* sgu_ln_b; const float* sgu_w_s; const float* sgu_b_s; const float* sgu_w_o;
    const float* ffn_w_gu; const float* ffn_w_down; const float* final_g;
    float* out; unsigned char* ws;
    int ph_lo, ph_hi;
};

enum { K_PREP = 0, K_NORM, K_CHANDFT, K_SEQDFT, K_RESID, K_GU, K_QKV, K_QKROPE, K_ATTN, K_WIN, K_SGU, K_FINAL };
struct PhaseDesc { unsigned char kind, layer, aux; };
constexpr int NPH = 31;
__device__ const PhaseDesc PHASES[NPH] = {
    {K_PREP, 0, 0},
    {K_NORM, 0, 0}, {K_CHANDFT, 0, 0}, {K_SEQDFT, 0, 0}, {K_RESID, 0, 0}, {K_NORM, 0, 1}, {K_GU, 0, 0}, {K_RESID, 0, 4},
    {K_NORM, 1, 0}, {K_QKV, 1, 0}, {K_QKROPE, 1, 0}, {K_ATTN, 1, 0}, {K_RESID, 1, 2}, {K_NORM, 1, 1}, {K_GU, 1, 0}, {K_RESID, 1, 4},
    {K_NORM, 2, 0}, {K_WIN, 2, 0}, {K_SGU, 2, 0}, {K_RESID, 2, 3}, {K_NORM, 2, 1}, {K_GU, 2, 0}, {K_RESID, 2, 4},
    {K_NORM, 3, 0}, {K_CHANDFT, 3, 0}, {K_SEQDFT, 3, 0}, {K_RESID, 3, 1}, {K_NORM, 3, 1}, {K_GU, 3, 0}, {K_RESID, 3, 4},
    {K_FINAL, 0, 0}};

__device__ __forceinline__ void transpose_item(const float* W, int K, int N, bf16_t* WT, int gu, LAS float* scr, int item, int lane) {
    const int nblk = N / 32, kb = item / nblk, nb = item % nblk, k0 = 64 * kb, n0 = 32 * nb;
#pragma unroll 8
    for (int i = 0; i < 32; ++i) { const int kk = 2 * i + (lane >> 5); scr[kk * 33 + (lane & 31)] = W[(size_t)(k0 + kk) * N + n0 + (lane & 31)]; }
    LDS_WAIT(); asm volatile("" ::: "memory");
    int d0 = n0;
    if (gu) { const int half = n0 / FF, j = n0 - half * FF; d0 = 256 * (j / 128) + 128 * half + (j % 128); }
    const int c = lane & 7;
#pragma unroll
    for (int j = 0; j < 4; ++j) { const int n = (lane >> 3) + 8 * j; const LAS float* s = scr + (8 * c) * 33 + n;
        u32x4 o; o.x = pk2(s[0 * 33], s[1 * 33]); o.y = pk2(s[2 * 33], s[3 * 33]); o.z = pk2(s[4 * 33], s[5 * 33]); o.w = pk2(s[6 * 33], s[7 * 33]);
        *(u32x4*)(WT + (size_t)(d0 + n) * K + k0 + 8 * c) = o; }
    LDS_WAIT(); asm volatile("" ::: "memory");
}

__device__ __forceinline__ void phase_prep(KPR p, LAS unsigned char* lds, int G) {
    const int tid = tid_opaque(), lane = tid & 63, wave = tid >> 6;
    unsigned char* ws = p.ws;
    for (int item = blockIdx.x; item < 4 * 48; item += G) {
        const int layer = item / 48, col0 = (item % 48) * 128;
        LAS float* csT = (LAS float*)lds;
        for (int idx = tid; idx < 32 * 1024; idx += NTHR) { const int b = idx >> 10, k = idx & 1023;
            const float c = b < 16 ? p.c_prompt[b * 1024 + k] : p.c_sample[(b - 16) * 1024 + k];
            csT[k * 32 + b] = c / (1.0f + __expf(-c)); }
        __syncthreads();
        float acc[32][2];
#pragma unroll
        for (int b = 0; b < 32; ++b) { acc[b][0] = 0.f; acc[b][1] = 0.f; }
        const float* wp = p.w_ada + ((size_t)layer * 1024 + wave * 128) * NMOD + col0 + 2 * lane;
#pragma unroll 4
        for (int kk = 0; kk < 128; ++kk) { const f32x2 wv = *(const f32x2*)(wp + (size_t)kk * NMOD); const LAS float* cr = csT + (wave * 128 + kk) * 32;
#pragma unroll
            for (int b = 0; b < 32; ++b) { const float cv = cr[b]; acc[b][0] += cv * wv.x; acc[b][1] += cv * wv.y; } }
        __syncthreads();
        LAS float* part = (LAS float*)lds;
#pragma unroll
        for (int b = 0; b < 32; ++b) *(LAS f32x2*)(part + (wave * 32 + b) * 128 + 2 * lane) = (f32x2){acc[b][0], acc[b][1]};
        __syncthreads();
        for (int o = tid; o < 32 * 128; o += NTHR) { const int b = o >> 7, cc = o & 127; float s = p.b_ada[layer * NMOD + col0 + cc];
#pragma unroll
            for (int w = 0; w < 8; ++w) s += part[(w * 32 + b) * 128 + cc];
            ((float*)(ws + WS_MOD))[((size_t)layer * 32 + b) * NMOD + col0 + cc] = s; }
        __syncthreads();
    }
    __syncthreads();
    {
        LAS float* scr = (LAS float*)(lds + wave * 16384);
        const int gw = blockIdx.x * NWAVES + wave, NGW = G * NWAVES;
        constexpr int I_SQ = (D / 64) * (D / 32), I_QKV = (D / 64) * (NQKV / 32), I_WIN = (D / 64) * (2048 / 32), I_GU = (D / 64) * (2 * FF / 32), I_DN = (FF / 64) * (D / 32);
        constexpr int NITEMS = 4 * I_SQ + I_QKV + I_WIN + 4 * I_GU + 4 * I_DN;
        for (int it = gw; it < NITEMS; it += NGW) {
            int r = it;
            if (r < 2 * I_SQ) { const int j = r / I_SQ; transpose_item(p.fnet_w_o + (size_t)j * D * D, D, D, (bf16_t*)(ws + WS_FNETW) + (size_t)j * D * D, 0, scr, r % I_SQ, lane); continue; } r -= 2 * I_SQ;
            if (r < I_SQ) { transpose_item(p.attn_w_o, D, D, (bf16_t*)(ws + WS_WAO), 0, scr, r, lane); continue; } r -= I_SQ;
            if (r < I_SQ) { transpose_item(p.sgu_w_o, D, D, (bf16_t*)(ws + WS_WSO), 0, scr, r, lane); continue; } r -= I_SQ;
            if (r < I_QKV) { transpose_item(p.attn_w_qkv, D, NQKV, (bf16_t*)(ws + WS_WQKV), 0, scr, r, lane); continue; } r -= I_QKV;
            if (r < I_WIN) { transpose_item(p.sgu_w_in, D, 2048, (bf16_t*)(ws + WS_WIN), 0, scr, r, lane); continue; } r -= I_WIN;
            if (r < 4 * I_GU) { const int j = r / I_GU; transpose_item(p.ffn_w_gu + (size_t)j * D * 2 * FF, D, 2 * FF, (bf16_t*)(ws + WS_WGU) + (size_t)j * D * 2 * FF, 1, scr, r % I_GU, lane); continue; } r -= 4 * I_GU;
            { const int j = r / I_DN; transpose_item(p.ffn_w_down + (size_t)j * FF * D, FF, D, (bf16_t*)(ws + WS_WDN) + (size_t)j * FF * D, 0, scr, r % I_DN, lane); }
        }
    }
    const size_t gt = (size_t)blockIdx.x * NTHR + tid, NGT = (size_t)G * NTHR;
    for (size_t i = gt; i < 8 * 128 * 128; i += NGT) ((bf16_t*)(ws + WS_WSB))[i] = (bf16_t)f2bf(p.sgu_w_s[i]);
    for (size_t i = gt; i < 512 * 256; i += NGT) { const int m = (int)(i >> 8), c = (int)(i & 255), l = m & 255; const float a = (float)((l * c) & 255) * (1.0f / 128.0f);
        ((bf16_t*)(ws + WS_DFTC))[i] = (bf16_t)f2bf(m < 256 ? cospif(a) : sinpif(a)); }
    for (size_t i = gt; i < (size_t)4096 * 8192 / 8; i += NGT) { const int k = (int)(i >> 10), j0 = (int)(i & 1023) * 8; float v[8];
#pragma unroll
        for (int e = 0; e < 8; ++e) { const int j = j0 + e, jj = j & 4095; const float a = (float)((k * jj) & 4095) * (1.0f / 2048.0f); v[e] = j < 4096 ? cospif(a) : -sinpif(a); }
        u32x4 o; o.x = pk2(v[0], v[1]); o.y = pk2(v[2], v[3]); o.z = pk2(v[4], v[5]); o.w = pk2(v[6], v[7]);
        *(u32x4*)((bf16_t*)(ws + WS_SEQ4) + i * 8) = o; }
    for (size_t i = gt; i < (size_t)2048 * 4096 / 8; i += NGT) { const int k = (int)(i >> 9), j0 = (int)(i & 511) * 8; float v[8];
#pragma unroll
        for (int e = 0; e < 8; ++e) { const int j = j0 + e, jj = j & 2047; const float a = (float)((k * jj) & 2047) * (1.0f / 1024.0f); v[e] = j < 2048 ? cospif(a) : -sinpif(a); }
        u32x4 o; o.x = pk2(v[0], v[1]); o.y = pk2(v[2], v[3]); o.z = pk2(v[4], v[5]); o.w = pk2(v[6], v[7]);
        *(u32x4*)((bf16_t*)(ws + WS_SEQ2) + i * 8) = o; }
}

__device__ __forceinline__ void phase_norm(KPR p, int layer, int which, int G) {
    const int tid = tid_opaque(), lane = tid & 63, wave = tid >> 6;
    const bool first = (layer == 0 && which == 0);
    const float* gam = (which ? p.norm2_g : p.norm1_g) + layer * D;
    const float* mod = (const float*)(p.ws + WS_MOD) + (size_t)layer * 32 * NMOD + (which ? 3 : 0) * D;
    bf16_t* H = (bf16_t*)(p.ws + WS_H);
    f32x4 gv[4];
#pragma unroll
    for (int j = 0; j < 4; ++j) gv[j] = *(const f32x4*)(gam + 4 * (lane + 64 * j));
    for (int row = blockIdx.x * NWAVES + wave; row < T; row += G * NWAVES) {
        const float* xr = first ? (row < TP ? p.x_prompt + (size_t)row * D : p.x_sample + (size_t)(row - TP) * D) : p.out + (size_t)row * D;
        f32x4 v[4]; float s = 0.f;
#pragma unroll
        for (int j = 0; j < 4; ++j) { v[j] = *(const f32x4*)(xr + 4 * (lane + 64 * j)); s += (v[j].x * v[j].x + v[j].y * v[j].y) + (v[j].z * v[j].z + v[j].w * v[j].w); }
        const float rstd = rsqrtf(wave_sum(s) * (1.0f / D) + EPS);
        const float* mr = mod + (size_t)seq_of(row) * NMOD;
#pragma unroll
        for (int j = 0; j < 4; ++j) { const int c = 4 * (lane + 64 * j); const f32x4 sh = *(const f32x4*)(mr + c), sc = *(const f32x4*)(mr + D + c);
            const f32x4 y = (v[j] * rstd) * gv[j]; const f32x4 h = y * (sc + 1.0f) + sh;
            u32x2 w; w.x = pk2(h.x, h.y); w.y = pk2(h.z, h.w);
            *(u32x2*)(H + (size_t)row * D + c) = w; }
    }
}

__device__ __forceinline__ void phase_final(KPR p, int G) {
    const int tid = tid_opaque(), lane = tid & 63, wave = tid >> 6;
    f32x4 gv[4];
#pragma unroll
    for (int j = 0; j < 4; ++j) gv[j] = *(const f32x4*)(p.final_g + 4 * (lane + 64 * j));
    for (int row = blockIdx.x * NWAVES + wave; row < T; row += G * NWAVES) {
        float* xr = p.out + (size_t)row * D;
        f32x4 v[4]; float s = 0.f;
#pragma unroll
        for (int j = 0; j < 4; ++j) { v[j] = *(const f32x4*)(xr + 4 * (lane + 64 * j)); s += (v[j].x * v[j].x + v[j].y * v[j].y) + (v[j].z * v[j].z + v[j].w * v[j].w); }
        const float rstd = rsqrtf(wave_sum(s) * (1.0f / D) + EPS);
#pragma unroll
        for (int j = 0; j < 4; ++j) *(f32x4*)(xr + 4 * (lane + 64 * j)) = (v[j] * rstd) * gv[j];
    }
}

__device__ __forceinline__ void phase_qkrope(KPR p, int G) {
    const int tid = tid_opaque(), lane = tid & 63, wave = tid >> 6;
    bf16_t* QKVb = (bf16_t*)(p.ws + WS_BIG);
    const int i0 = 2 * (lane & 15);
    const float f0 = 1.0f / powf(10000.0f, (float)(2 * i0) / 64.0f), f1 = 1.0f / powf(10000.0f, (float)(2 * (i0 + 1)) / 64.0f);
    const bool x2 = (lane & 31) >= 16, colhalf = lane >= 32;
    const f32x2 qg = *(const f32x2*)(p.attn_q_g + 2 * lane), kg = *(const f32x2*)(p.attn_k_g + 2 * lane);
    for (int row = blockIdx.x * NWAVES + wave; row < T; row += G * NWAVES) {
        const int sq = seq_of(row), t = row - seq_start(sq);
        const float pos = (float)(colhalf ? (t & 63) : (t >> 6));
        float s0, c0, s1, c1; sincosf(pos * f0, &s0, &c0); sincosf(pos * f1, &s1, &c1);
        unsigned* rp = (unsigned*)(QKVb + (size_t)row * NQKV) + lane;
        unsigned raw[10];
#pragma unroll
        for (int h = 0; h < 10; ++h) raw[h] = rp[h * 64];
#pragma unroll
        for (int h = 0; h < 10; ++h) {
            const float v0 = bf2f((unsigned short)(raw[h] & 0xffffu)), v1 = bf2f((unsigned short)(raw[h] >> 16));
            const float rstd = rsqrtf(wave_sum(v0 * v0 + v1 * v1) * (1.0f / 128.0f) + EPS);
            const f32x2 g = h < 8 ? qg : kg;
            const float y0 = v0 * rstd * g.x, y1 = v1 * rstd * g.y;
            const float z0 = __shfl_xor(y0, 16), z1 = __shfl_xor(y1, 16);
            const float o0 = x2 ? (y0 * c0 + z0 * s0) : (y0 * c0 - z0 * s0);
            const float o1 = x2 ? (y1 * c1 + z1 * s1) : (y1 * c1 - z1 * s1);
            rp[h * 64] = pk2(o0, o1);
        }
    }
}

__device__ __forceinline__ void phase_attn(KPR p, char* lds, int G) {
    const bf16_t* QKVb = (const bf16_t*)(p.ws + WS_BIG); bf16_t* O = (bf16_t*)(p.ws + WS_H);
    const int bx = blockIdx.x, vcu = (G % 8 == 0) ? (bx % 8) * (G / 8) + bx / 8 : bx;
    for (int u = vcu; u < 2048 + 1024; u += G) {
        int b, kvh, g, qb, S;
        if (u < 2048) { b = u >> 7; const int r = u & 127; kvh = r >> 6; g = (r >> 4) & 3; qb = r & 15; S = SP; }
        else { const int v = u - 2048; b = 16 + (v >> 6); const int r = v & 63; kvh = r >> 5; g = (r >> 3) & 3; qb = r & 7; S = SS; }
        const int h = kvh * 4 + g; const size_t r0 = (size_t)seq_start(b);
        att::attn_dense_body(QKVb + (r0 + (size_t)qb * 256) * NQKV + h * 128, QKVb + r0 * NQKV + 1024 + kvh * 128, QKVb + r0 * NQKV + 1280 + kvh * 128,
                             O + (r0 + (size_t)qb * 256) * D + h * 128, S, lds);
    }
}

__device__ __forceinline__ void phase_sgu(KPR p, char* lds, int G) {
    const int tid = tid_opaque(), lane = tid & 63, wave = tid >> 6, r32 = lane & 31, hi = lane >> 5;
    const bf16_t* UV = (const bf16_t*)(p.ws + WS_BIG); bf16_t* OUT = (bf16_t*)(p.ws + WS_H); const bf16_t* WSB = (const bf16_t*)(p.ws + WS_WSB);
    constexpr int VS = 136;
    bf16_t* VT = (bf16_t*)lds;
    float* st = (float*)(lds + 128 * VS * 2);
    for (int ci = blockIdx.x; ci < T / 128; ci += G) {
        const size_t r0 = (size_t)ci * 128;
        for (int rr = 0; rr < 16; ++rr) { const int j = wave * 16 + rr; const bf16_t* vp = UV + (r0 + j) * 2048 + 1024 + 8 * lane;
            const bf16x8 a = *(const bf16x8*)vp, b = *(const bf16x8*)(vp + 512); float x[16]; float s = 0.f;
#pragma unroll
            for (int e = 0; e < 8; ++e) { x[e] = bf2f((unsigned short)a[e]); x[8 + e] = bf2f((unsigned short)b[e]); }
#pragma unroll
            for (int e = 0; e < 16; ++e) s += x[e];
            const float mean = wave_sum(s) * (1.0f / 1024.0f); float q = 0.f;
#pragma unroll
            for (int e = 0; e < 16; ++e) { const float d = x[e] - mean; q += d * d; }
            const float rstd = rsqrtf(wave_sum(q) * (1.0f / 1024.0f) + EPS);
            if (lane == 0) { st[2 * j] = mean; st[2 * j + 1] = rstd; } }
        __syncthreads();
        for (int g = 0; g < 8; ++g) {
            { const int j = tid & 127; const float mean = st[2 * j], rstd = st[2 * j + 1];
#pragma unroll
              for (int it = 0; it < 4; ++it) { const int c0 = 8 * ((tid >> 7) + 4 * it);
                const bf16x8 a = *(const bf16x8*)(UV + (r0 + j) * 2048 + 1024 + g * 128 + c0);
#pragma unroll
                for (int e = 0; e < 8; ++e) { const int c = c0 + e; const float vn = (bf2f((unsigned short)a[e]) - mean) * rstd * p.sgu_ln_g[g * 128 + c] + p.sgu_ln_b[g * 128 + c];
                    VT[c * VS + j] = (bf16_t)f2bf(vn); } } }
            __syncthreads();
            const int it_ = wave >> 1, ct0 = (wave & 1) * 2;
            f32x16 acc0 = {}, acc1 = {};
            const bf16_t* ap = WSB + (size_t)g * 16384 + (32 * it_ + r32) * 128 + 8 * hi;
#pragma unroll
            for (int ks = 0; ks < 8; ++ks) {
                const bf16x8 af = *(const bf16x8*)(ap + 16 * ks);
                const bf16x8 b0 = *(const bf16x8*)(VT + (32 * ct0 + r32) * VS + 16 * ks + 8 * hi);
                const bf16x8 b1 = *(const bf16x8*)(VT + (32 * (ct0 + 1) + r32) * VS + 16 * ks + 8 * hi);
                acc0 = __builtin_amdgcn_mfma_f32_32x32x16_bf16(af, b0, acc0, 0, 0, 0);
                acc1 = __builtin_amdgcn_mfma_f32_32x32x16_bf16(af, b1, acc1, 0, 0, 0);
            }
#pragma unroll
            for (int r = 0; r < 16; ++r) { const int i = 32 * it_ + att::crow(r, hi); const float bs = p.sgu_b_s[g * 128 + i];
                const size_t ro = r0 + i; const int c_0 = g * 128 + 32 * ct0 + r32, c_1 = c_0 + 32;
                const float u0 = bf2f(UV[ro * 2048 + c_0]), u1 = bf2f(UV[ro * 2048 + c_1]);
                OUT[ro * D + c_0] = (bf16_t)f2bf(u0 * (acc0[r] + bs)); OUT[ro * D + c_1] = (bf16_t)f2bf(u1 * (acc1[r] + bs)); }
            __syncthreads();
        }
    }
}

#define XB_TMO      128
#define XB_XCNT(j)  (256  + 64 * (j))
#define XB_XSUB(j)  (1280 + 64 * (j))
#define XB_XGEN(j)  (2304 + 64 * (j))
#define XB_TOP      3328
#define XB_TOPGEN   3392
#define XCD_BAR_WORDS 3456
#define XB_SPIN_CAP (1u << 22)
__device__ __forceinline__ unsigned xb_ld(unsigned* p)              { return __hip_atomic_load(p, __ATOMIC_RELAXED, __HIP_MEMORY_SCOPE_AGENT); }
__device__ __forceinline__ unsigned xb_add(unsigned* p, unsigned v) { return __hip_atomic_fetch_add(p, v, __ATOMIC_RELAXED, __HIP_MEMORY_SCOPE_AGENT); }
__device__ __forceinline__ unsigned xb_xcc_id() { return (unsigned)__builtin_amdgcn_s_getreg((3 << 11) | 20) & 0xFu; }
#define XB_SPIN(cond, bar) do { unsigned _sp = 0; while (cond) { __builtin_amdgcn_s_sleep(1); \
    if ((++_sp & 255u) == 0u) { if (xb_ld(&(bar)[XB_TMO])) break; if (_sp > XB_SPIN_CAP) { atomicAdd(&(bar)[XB_TMO], 1u); break; } } } } while (0)
struct XcdBarrier { unsigned* bar; unsigned x; volatile LAS unsigned* st; };
__device__ __forceinline__ XcdBarrier xcd_barrier_post(unsigned* bar, volatile LAS unsigned* st) {
    XcdBarrier b; b.bar = bar; b.x = xb_xcc_id(); b.st = st;
    if (threadIdx.x == 0) (void)xb_add(&bar[XB_XCNT(b.x)], 1u);
    return b;
}
__device__ __forceinline__ void xcd_barrier_complete(unsigned* bar, unsigned x, unsigned& nloc, unsigned& nx) {
    const unsigned G = gridDim.x * gridDim.y * gridDim.z;
    unsigned sum, cnt, mine, sp = 0u;
    for (;;) {
        sum = 0u; cnt = 0u; mine = 0u;
#pragma unroll
        for (unsigned j = 0; j < 16; ++j) { const unsigned c = xb_ld(&bar[XB_XCNT(j)]); sum += c; cnt += (c > 0u) ? 1u : 0u; mine = (j == x) ? c : mine; }
        if (sum == G) break;
        __builtin_amdgcn_s_sleep(1);
        if ((++sp & 255u) == 0u) { if (xb_ld(&bar[XB_TMO])) break; if (sp > XB_SPIN_CAP) { atomicAdd(&bar[XB_TMO], 1u); break; } }
    }
    nloc = mine > 0u ? mine : 1u; nx = cnt > 0u ? cnt : 1u;
}
__device__ __forceinline__ void xcd_barrier(const XcdBarrier& b) {
    asm volatile("s_waitcnt vmcnt(0)" ::: "memory");
    __syncthreads();
    if (threadIdx.x == 0) {
        unsigned* bar = b.bar;
        __builtin_amdgcn_s_waitcnt(0);
        unsigned nloc = b.st[0], nx = b.st[1];
        if (nloc == 0u) { xcd_barrier_complete(bar, b.x, nloc, nx); b.st[0] = nloc; b.st[1] = nx; }
        const unsigned old = xb_add(&bar[XB_XSUB(b.x)], 1u);
        const unsigned gen = old / nloc;
        if (old + 1u == (gen + 1u) * nloc) {
            __builtin_amdgcn_fence(__ATOMIC_RELEASE, "agent");
            asm volatile("s_waitcnt vmcnt(0)" ::: "memory");
            const unsigned og = xb_add(&bar[XB_TOP], 1u);
            const unsigned tg = og / nx;
            if (og + 1u == (tg + 1u) * nx) xb_add(&bar[XB_TOPGEN], 1u);
            else XB_SPIN(xb_ld(&bar[XB_TOPGEN]) == tg, bar);
            __builtin_amdgcn_fence(__ATOMIC_ACQUIRE, "agent");
            xb_add(&bar[XB_XGEN(b.x)], 1u);
            asm volatile("s_waitcnt vmcnt(0)" ::: "memory");
        } else {
            XB_SPIN(xb_ld(&bar[XB_XGEN(b.x)]) == gen, bar);
            __builtin_amdgcn_fence(__ATOMIC_ACQUIRE, "agent");
            asm volatile("s_waitcnt vmcnt(0)" ::: "memory");
        }
    }
    __syncthreads();
}

__global__ void __launch_bounds__(NTHR, 2) mega_fwd(Params p_arg) {
    extern __shared__ __attribute__((aligned(16))) unsigned char lds[];
    LAS unsigned char* ldsl = (LAS unsigned char*)lds;
    const int G = gridDim.x;
    const __attribute__((address_space(4))) Params* kp = (const __attribute__((address_space(4))) Params*)__builtin_amdgcn_kernarg_segment_ptr();
    const int ph_lo = kp->ph_lo, ph_hi = kp->ph_hi;
    volatile LAS unsigned* xst = (volatile LAS unsigned*)(ldsl + 131072 + 64);
    if (threadIdx.x == 0) { xst[0] = 0u; xst[1] = 0u; }
    __syncthreads();
    XcdBarrier xbar; xbar.bar = (unsigned*)(kp->ws + WS_BAR); xbar.x = 0; xbar.st = xst;
    if (ph_hi - ph_lo > 1) xbar = xcd_barrier_post((unsigned*)(kp->ws + WS_BAR), xst);
    for (int ph = ph_lo; ph < ph_hi; ++ph) {
        asm volatile("" : "+s"(kp));
        KPR p = *kp;
        unsigned char* ws = p.ws;
        const PhaseDesc pd = PHASES[ph];
        const int layer = pd.layer;
        switch (pd.kind) {
        case K_PREP: if (EN(K_PREP)) phase_prep(p, ldsl, G); break;
        case K_NORM: if (EN(K_NORM)) phase_norm(p, layer, pd.aux, G); break;
        case K_FINAL: if (EN(K_FINAL)) phase_final(p, G); break;
        case K_QKROPE: if (EN(K_QKROPE)) phase_qkrope(p, G); break;
        case K_ATTN: if (EN(K_ATTN)) phase_attn(p, (char*)lds, G); break;
        case K_SGU: if (EN(K_SGU)) phase_sgu(p, (char*)lds, G); break;
        case K_CHANDFT: if (EN(K_CHANDFT)) {
            pg8::Gemm g{(const bf16_t*)(ws + WS_DFTC), (const bf16_t*)(ws + WS_H), 256, D, 256, 1, 0, (size_t)256 * 2};
            pg8::StaticOrder S; S.init(8, T / 256, G, blockIdx.x);
            pg8::EpiChanDft E{(bf16_t*)(ws + WS_BIG)};
            pg8::gemm_phase<pg8::EpiChanDft, pg8::StaticOrder, true, true>(ldsl, g, S, E);
        } break;
        case K_SEQDFT: if (EN(K_SEQDFT)) {
            for (int part = 0; part < 2; ++part) {
                const int S_ = part ? SS : SP;
                pg8::Gemm g{(const bf16_t*)(ws + (part ? WS_SEQ2 : WS_SEQ4)), (const bf16_t*)(ws + WS_BIG) + (part ? (size_t)16 * 1024 * 8192 : 0), 2 * S_, 2 * S_, 2 * S_, part ? 3 : 4, 0, (size_t)1024 * 2 * S_ * 2};
                pg8::StaticOrder S; S.init((part ? TS : TP) / 256, 4, G, blockIdx.x);
                pg8::EpiBf16<0> E{(bf16_t*)(ws + WS_H) + (part ? (size_t)TP * D : 0), D, part ? 0.022097086912079608f : 0.015625f};
                pg8::gemm_phase<pg8::EpiBf16<0>, pg8::StaticOrder, true, true>(ldsl, g, S, E);
            }
        } break;
        case K_QKV: if (EN(K_QKV)) {
            pg8::Gemm g{(const bf16_t*)(ws + WS_H), (const bf16_t*)(ws + WS_WQKV), D, D, D, 30, 0, 0};
            pg8::StaticOrder S; S.init(T / 256, NQKV / 256, G, blockIdx.x);
            pg8::EpiBf16<0> E{(bf16_t*)(ws + WS_BIG), NQKV, 1.0f};
            pg8::gemm_phase<pg8::EpiBf16<0>, pg8::StaticOrder, true, true>(ldsl, g, S, E);
        } break;
        case K_WIN: if (EN(K_WIN)) {
            pg8::Gemm g{(const bf16_t*)(ws + WS_H), (const bf16_t*)(ws + WS_WIN), D, D, D, 30, 0, 0};
            pg8::StaticOrder S; S.init(T / 256, 2048 / 256, G, blockIdx.x);
            pg8::EpiBf16<1> E{(bf16_t*)(ws + WS_BIG), 2048, 1.0f};
            pg8::gemm_phase<pg8::EpiBf16<1>, pg8::StaticOrder, true, true>(ldsl, g, S, E);
        } break;
        case K_GU: if (EN(K_GU)) {
            pg8::Gemm g{(const bf16_t*)(ws + WS_H), (const bf16_t*)(ws + WS_WGU) + (size_t)layer * D * 2 * FF, D, D, D, 30, 0, 0};
            pg8::StaticOrder S; S.init(T / 256, 2 * FF / 256, G, blockIdx.x);
            pg8::EpiSwiGlu E{(bf16_t*)(ws + WS_BIG)};
            pg8::gemm_phase<pg8::EpiSwiGlu, pg8::StaticOrder, true, true>(ldsl, g, S, E);
        } break;
        case K_RESID: if (EN(K_RESID)) {
            const int aux = pd.aux; const bool first = (layer == 0 && aux != 4);
            const bf16_t* A = (const bf16_t*)(ws + (aux == 4 ? WS_BIG : WS_H));
            const bf16_t* W = aux == 0 ? (const bf16_t*)(ws + WS_FNETW) : aux == 1 ? (const bf16_t*)(ws + WS_FNETW) + (size_t)D * D : aux == 2 ? (const bf16_t*)(ws + WS_WAO)
                            : aux == 3 ? (const bf16_t*)(ws + WS_WSO) : (const bf16_t*)(ws + WS_WDN) + (size_t)layer * FF * D;
            const int K = aux == 4 ? FF : D;
            pg8::Gemm g{A, W, K, K, K, 30, 0, 0};
            pg8::StaticOrder S; S.init(T / 256, D / 256, G, blockIdx.x);
            pg8::EpiResid E{first ? p.x_prompt : p.out, first ? p.x_sample - (size_t)TP * D : p.out, p.out,
                            (const float*)(ws + WS_MOD) + (size_t)layer * 32 * NMOD + (aux == 4 ? 5 : 2) * D};
            pg8::gemm_phase<pg8::EpiResid, pg8::StaticOrder, true, true>(ldsl, g, S, E);
        } break;
        }
        if (ph + 1 < ph_hi) {
            if (ph == ph_lo) { __threadfence(); cg::this_grid().sync(); }
            else xcd_barrier(xbar);
        }
    }
}

extern "C" void kernel_launch(void* const* d_in, const int* in_sizes, int n_in, void* d_out, int out_size, void* d_ws, size_t ws_size, hipStream_t stream) {
    static int grid = 0;
    if (grid == 0) {
        if (n_in != 22 || in_sizes[0] != TP * D || in_sizes[1] != TS * D || out_size != T * D || ws_size < WS_END) {
            fprintf(stderr, "kernel_launch: shape mismatch n_in %d in0 %d in1 %d out %d ws %zu (need %zu)\n", n_in, n_in > 0 ? in_sizes[0] : -1, n_in > 1 ? in_sizes[1] : -1, out_size, ws_size, (size_t)WS_END);
            grid = -1; return; }
        int dev = 0, cus = 0, per_cu = 0;
        if (hipGetDevice(&dev) != hipSuccess || hipDeviceGetAttribute(&cus, hipDeviceAttributeMultiprocessorCount, dev) != hipSuccess) { grid = -1; return; }
        if (hipFuncSetAttribute((const void*)mega_fwd, hipFuncAttributeMaxDynamicSharedMemorySize, LDS_BYTES) != hipSuccess) { fprintf(stderr, "kernel_launch: hipFuncSetAttribute failed\n"); grid = -1; return; }
        if (hipOccupancyMaxActiveBlocksPerMultiprocessor(&per_cu, (const void*)mega_fwd, NTHR, LDS_BYTES) != hipSuccess || per_cu < 1) { fprintf(stderr, "kernel_launch: occupancy query gave %d\n", per_cu); per_cu = 1; }
        (void)hipGetLastError();
        grid = cus * per_cu;
        fprintf(stderr, "kernel_launch: grid %d (cus %d x %d)\n", grid, cus, per_cu);
    }
    if (grid < 0) return;
    Params p{};
    p.x_prompt = (const float*)d_in[0]; p.x_sample = (const float*)d_in[1]; p.c_prompt = (const float*)d_in[2]; p.c_sample = (const float*)d_in[3];
    p.norm1_g = (const float*)d_in[4]; p.norm2_g = (const float*)d_in[5]; p.w_ada = (const float*)d_in[6]; p.b_ada = (const float*)d_in[7];
    p.fnet_w_o = (const float*)d_in[8]; p.attn_w_qkv = (const float*)d_in[9]; p.attn_q_g = (const float*)d_in[10]; p.attn_k_g = (const float*)d_in[11]; p.attn_w_o = (const float*)d_in[12];
    p.sgu_w_in = (const float*)d_in[13]; p.sgu_ln_g = (const float*)d_in[14]; p.sgu_ln_b = (const float*)d_in[15]; p.sgu_w_s = (const float*)d_in[16]; p.sgu_b_s = (const float*)d_in[17]; p.sgu_w_o = (const float*)d_in[18];
    p.ffn_w_gu = (const float*)d_in[19]; p.ffn_w_down = (const float*)d_in[20]; p.final_g = (const float*)d_in[21];
    p.out = (float*)d_out; p.ws = (unsigned char*)d_ws;
#if MK_SINGLE
    if (hipMemsetAsync((char*)d_ws + WS_BAR, 0, BAR_BYTES, stream) != hipSuccess) { fprintf(stderr, "kernel_launch: memset failed\n"); return; }
    p.ph_lo = 0; p.ph_hi = NPH;
    void* args[] = {&p};
    hipError_t e = hipLaunchCooperativeKernel((const void*)mega_fwd, dim3(grid), dim3(NTHR), args, LDS_BYTES, stream);
    if (e != hipSuccess) fprintf(stderr, "kernel_launch: cooperative launch failed: %s (grid %d)\n", hipGetErrorString(e), grid);
#else
    for (int ph = 0; ph < NPH; ++ph) {
        p.ph_lo = ph; p.ph_hi = ph + 1;
        hipLaunchKernelGGL(mega_fwd, dim3(grid), dim3(NTHR), LDS_BYTES, stream, p);
    }
    const hipError_t le = hipPeekAtLastError();
    if (le != hipSuccess) fprintf(stderr, "kernel_launch: launch failed: %s\n", hipGetErrorName(le));
#endif
}
```

```cpp
#include <hip/hip_runtime.h>
#include <hip/hip_cooperative_groups.h>
#include <cstdio>
#include <cstdint>
namespace cg = cooperative_groups;

#ifndef MK_EN
#define MK_EN 0x1FFF
#endif
#define EN(k) (((MK_EN) >> (k)) & 1)
#ifndef MK_SINGLE
#define MK_SINGLE 1
#endif

#define LAS __attribute__((address_space(3)))
typedef unsigned short bf16_t;
typedef short bf16x8 __attribute__((ext_vector_type(8)));
typedef short s16x4 __attribute__((ext_vector_type(4)));
typedef float f32x2 __attribute__((ext_vector_type(2)));
typedef float f32x4 __attribute__((ext_vector_type(4)));
typedef float f32x16 __attribute__((ext_vector_type(16)));
typedef unsigned u32x2 __attribute__((ext_vector_type(2)));
typedef unsigned u32x4 __attribute__((ext_vector_type(4)));

constexpr int D = 1024, TP = 65536, TS = 32768, T = TP + TS, SP = 4096, SS = 2048, FF = 2816, NQKV = 1536, NMOD = 6144;
constexpr float EPS = 1e-6f;
constexpr int NWAVES = 8, NTHR = 512;
constexpr int LDS_BYTES = 147456;

__device__ __forceinline__ int seq_of(int row) { return row < TP ? (row >> 12) : 16 + ((row - TP) >> 11); }
__device__ __forceinline__ int seq_start(int s) { return s < 16 ? (s << 12) : TP + ((s - 16) << 11); }
__device__ __forceinline__ int seq_len(int s) { return s < 16 ? SP : SS; }
__device__ __forceinline__ size_t zt_base(int s) { return s < 16 ? (size_t)s * (1024u * 8192u) : (size_t)16 * (1024u * 8192u) + (size_t)(s - 16) * (1024u * 4096u); }

constexpr size_t MiB = 1u << 20;
constexpr size_t WS_MOD = 0;
constexpr size_t WS_DFTC = 3 * MiB;
constexpr size_t WS_WSB = WS_DFTC + 256 * 1024;
constexpr size_t WS_BAR = WS_WSB + 256 * 1024, BAR_BYTES = 16384;
constexpr size_t WS_FNETW = 4 * MiB;
constexpr size_t WS_WQKV = 8 * MiB;
constexpr size_t WS_WAO = 11 * MiB;
constexpr size_t WS_WIN = 13 * MiB;
constexpr size_t WS_WSO = 17 * MiB;
constexpr size_t WS_WGU = 19 * MiB;
constexpr size_t WS_WDN = 63 * MiB;
constexpr size_t WS_M1P = 85 * MiB;
constexpr size_t WS_M1S = 93 * MiB;
constexpr size_t WS_H = 165 * MiB;
constexpr size_t WS_BIG = 357 * MiB;
constexpr size_t WS_Y = 165 * MiB;
constexpr size_t WS_ZT = 549 * MiB;
constexpr size_t WS_END = 933 * MiB;

__device__ __forceinline__ unsigned f2bf(float f) { unsigned u = __builtin_bit_cast(unsigned, f); return (u + 0x7fffu + ((u >> 16) & 1u)) >> 16; }
__device__ __forceinline__ unsigned pk2(float lo, float hi) { return f2bf(lo) | (f2bf(hi) << 16); }
__device__ __forceinline__ float bf2f(unsigned short b) { return __builtin_bit_cast(float, ((unsigned)b) << 16); }
__device__ __forceinline__ unsigned cvt_pk_bf16(float lo, float hi) { unsigned r; asm volatile("v_cvt_pk_bf16_f32 %0, %1, %2" : "=v"(r) : "v"(lo), "v"(hi)); return r; }
__device__ __forceinline__ float wave_sum(float v) {
#pragma unroll
    for (int o = 1; o < 64; o <<= 1) v += __shfl_xor(v, o);
    return v;
}
__device__ __forceinline__ int tid_opaque() { int t = threadIdx.x; asm volatile("" : "+v"(t)); return t; }
#define LDS_WAIT() asm volatile("s_waitcnt lgkmcnt(0)" ::: "memory")

namespace pg8 {
constexpr int BM = 256, BK = 64, HALF = 128, HTB = HALF * BK * 2, STAGE_BYTES = 8 * HTB, NXCD = 8, WGM = 8;
__host__ __device__ __forceinline__ int lds_byte(int r, int c) { const int st = (r >> 4) * 2 + (c >> 5), rr = r & 15, cc = c & 31, ob = rr * 64 + cc * 2; return st * 1024 + (ob ^ (((ob >> 9) & 1) << 5)); }
__host__ __device__ __forceinline__ void stage_rc(int b, int& R, int& C) { const int st = b / 1024, sb = b % 1024, swz = sb ^ (((sb >> 9) & 1) << 5); R = (st >> 1) * 16 + swz / 64; C = (st & 1) * 32 + (swz % 64) / 2; }
__host__ __device__ __forceinline__ int perm32(int rho) { const int n = rho >> 4, i = rho & 15; return 8 * (i >> 2) + 4 * n + (i & 3); }

struct Unit { int pm, pn; };
struct Gemm { const bf16_t* A; const bf16_t* Bt; int lda, ldb, K; int am0, ash, am1; size_t sA; int bsh, bm0; size_t sB1, sB2, sB; };
__device__ __forceinline__ Gemm plain_gemm(const bf16_t* A, const bf16_t* Bt, int lda, int ldb, int K) { return Gemm{A, Bt, lda, ldb, K, 0x3fffffff, 30, 0, 0, 0, 0, (size_t)256 * ldb * 2, 0, 0}; }

struct StaticOrder {
    int nM, nN, nwg, G, c;
    __device__ void init(int nM_, int nN_, int G_, int c_) { nM = nM_; nN = nN_; nwg = nM * nN; G = G_; c = c_; }
    __device__ bool next(int i, Unit& u) const {
        const long L = (long)i * G + c; if (L >= nwg) return false;
        int wgid = (int)L; { const int q = nwg / NXCD, r = nwg % NXCD, xcd = wgid % NXCD, off = wgid / NXCD; wgid = (xcd < r ? xcd * (q + 1) : r * (q + 1) + (xcd - r) * q) + off; }
        const int nig = WGM * nN, gid = wgid / nig, fm = gid * WGM, gsz = (nM - fm) < WGM ? (nM - fm) : WGM;
        u.pm = fm + ((wgid % nig) % gsz); u.pn = (wgid % nig) / gsz; return true;
    }
};

__device__ __forceinline__ f32x2 gelu_pk(f32x2 v) {
    const f32x2 av = __builtin_elementwise_abs(v), d = av * 0.2316418882f + 1.0f;
    f32x2 t; t.x = __builtin_amdgcn_rcpf(d.x); t.y = __builtin_amdgcn_rcpf(d.y);
    f32x2 q = t * 0.5307027145f + (-0.7265760135f); q = q * t + 0.7107068705f; q = q * t + (-0.142248368f); q = q * t + 0.127414796f; q = q * t;
    const f32x2 s = (v * v) * (-0.72134752044f);
    f32x2 e; e.x = __builtin_amdgcn_exp2f(s.x); e.y = __builtin_amdgcn_exp2f(s.y);
    const f32x2 m = v * (q * e), r = v - m;
    f32x2 o; o.x = v.x < 0.f ? m.x : r.x; o.y = v.y < 0.f ? m.y : r.y; return o;
}

template <int ACT> struct EpiBf16 {
    static constexpr bool PERM = true;
    bf16_t* O; int ldc; float scale;
    __device__ __forceinline__ void operator()(const f32x4 (&acc)[2][2][4][2], const Unit& u, int wr, int wc, int fr, int fq) const {
        const unsigned row0 = u.pm * BM + wr * 64 + fr, col0 = u.pn * BM + wc * 32 + 8 * fq;
        char* Ob = (char*)O;
#pragma unroll
        for (int ai = 0; ai < 2; ++ai)
#pragma unroll
            for (int m = 0; m < 4; ++m) { const unsigned ob = ((row0 + ai * HALF + m * 16) * (unsigned)ldc + col0) * 2u;
#pragma unroll
                for (int bj = 0; bj < 2; ++bj) { f32x4 v0 = acc[ai][bj][m][0], v1 = acc[ai][bj][m][1];
                    if (ACT == 1) { f32x2 a = gelu_pk((f32x2){v0[0], v0[1]}), b = gelu_pk((f32x2){v0[2], v0[3]}), c = gelu_pk((f32x2){v1[0], v1[1]}), d = gelu_pk((f32x2){v1[2], v1[3]});
                        v0 = (f32x4){a.x, a.y, b.x, b.y}; v1 = (f32x4){c.x, c.y, d.x, d.y}; }
                    v0 = v0 * scale; v1 = v1 * scale;
                    u32x4 w; w.x = cvt_pk_bf16(v0[0], v0[1]); w.y = cvt_pk_bf16(v0[2], v0[3]); w.z = cvt_pk_bf16(v1[0], v1[1]); w.w = cvt_pk_bf16(v1[2], v1[3]);
                    *(u32x4*)(Ob + (size_t)(ob + bj * HALF * 2)) = w; } }
    }
};
struct EpiChanDft {
    static constexpr bool PERM = true;
    bf16_t* Zt;
    __device__ __forceinline__ void operator()(const f32x4 (&acc)[2][2][4][2], const Unit& u, int wr, int wc, int fr, int fq) const {
        const int g = u.pm >> 1, cs = u.pm & 1;
        char* base = (char*)Zt + ((size_t)u.pn * 1024 * 512 + (size_t)cs * 256) * 2;
        const unsigned lo = ((unsigned)(g * 256 + wr * 64 + fr) * 512u + (unsigned)(wc * 32 + 8 * fq)) * 2u;
#pragma unroll
        for (int ai = 0; ai < 2; ++ai)
#pragma unroll
            for (int m = 0; m < 4; ++m) { const unsigned ob = lo + (unsigned)(ai * HALF + m * 16) * 1024u;
#pragma unroll
                for (int bj = 0; bj < 2; ++bj) { const f32x4 v0 = acc[ai][bj][m][0] * 0.0625f, v1 = acc[ai][bj][m][1] * 0.0625f;
                    u32x4 w; w.x = cvt_pk_bf16(v0[0], v0[1]); w.y = cvt_pk_bf16(v0[2], v0[3]); w.z = cvt_pk_bf16(v1[0], v1[1]); w.w = cvt_pk_bf16(v1[2], v1[3]);
                    *(u32x4*)(base + (size_t)(ob + bj * HALF * 2)) = w; }
                asm volatile("" ::: "memory"); }
    }
};
struct EpiSwiGlu {
    static constexpr bool PERM = true;
    bf16_t* Hd;
    __device__ __forceinline__ void operator()(const f32x4 (&acc)[2][2][4][2], const Unit& u, int wr, int wc, int fr, int fq) const {
        const unsigned row0 = u.pm * BM + wr * 64 + fr, col0 = u.pn * HALF + wc * 32 + 8 * fq;
        char* Hb = (char*)Hd;
#pragma unroll
        for (int ai = 0; ai < 2; ++ai)
#pragma unroll
            for (int m = 0; m < 4; ++m) { const unsigned ob = ((row0 + ai * HALF + m * 16) * (unsigned)FF + col0) * 2u;
                float o[8];
#pragma unroll
                for (int n = 0; n < 2; ++n)
#pragma unroll
                    for (int e = 0; e < 4; ++e) { const float gv = acc[ai][0][m][n][e], uv = acc[ai][1][m][n][e];
                        const float sg = gv * __builtin_amdgcn_rcpf(1.0f + __builtin_amdgcn_exp2f(-1.4426950408889634f * gv)); o[n * 4 + e] = sg * uv; }
                u32x4 w; w.x = cvt_pk_bf16(o[0], o[1]); w.y = cvt_pk_bf16(o[2], o[3]); w.z = cvt_pk_bf16(o[4], o[5]); w.w = cvt_pk_bf16(o[6], o[7]);
                *(u32x4*)(Hb + (size_t)ob) = w; }
    }
};
struct EpiResid {
    static constexpr bool PERM = false;
    const float* srcP; const float* srcS;
    float* out; const float* gate;
    __device__ __forceinline__ void operator()(const f32x4 (&acc)[2][2][4][2], const Unit& u, int wr, int wc, int fr, int fq) const {
        const unsigned row0 = u.pm * BM + wr * 64 + fr, col0 = u.pn * BM + wc * 32 + 4 * fq;
        const int sq = seq_of(u.pm * BM); const float* gp = gate + (size_t)sq * NMOD; const char* sb = (const char*)((u.pm * BM < TP) ? srcP : srcS); char* ob_ = (char*)out;
        f32x4 gv[2][2];
#pragma unroll
        for (int bj = 0; bj < 2; ++bj)
#pragma unroll
            for (int n = 0; n < 2; ++n) gv[bj][n] = *(const f32x4*)(gp + col0 + bj * HALF + n * 16);
#pragma unroll
        for (int ai = 0; ai < 2; ++ai)
#pragma unroll
            for (int m = 0; m < 4; ++m) { const unsigned off = ((row0 + ai * HALF + m * 16) * (unsigned)D + col0) * 4u;
#pragma unroll
                for (int bj = 0; bj < 2; ++bj)
#pragma unroll
                    for (int n = 0; n < 2; ++n) { const unsigned o2 = off + (bj * HALF + n * 16) * 4; const f32x4 xs = *(const f32x4*)(sb + (size_t)o2);
                        *(f32x4*)(ob_ + (size_t)o2) = xs + gv[bj][n] * acc[ai][bj][m][n]; }
                asm volatile("" ::: "memory"); }
    }
};

template <class Epi, class Sched, bool ALIGN_EPI, bool SP2>
__device__ __forceinline__ void gemm_phase(LAS unsigned char* lds, const Gemm g, const Sched& S, const Epi& E) {
    const int tid = tid_opaque(), wid = __builtin_amdgcn_readfirstlane(tid >> 6), lane = tid & 63, wr = wid >> 2, wc = wid & 3, fr = lane & 15, fq = lane >> 4;
    int K = g.K; asm volatile("" : "+s"(K));
    const int nt = K / BK;
    unsigned voffA[2], voffB[2];
#pragma unroll
    for (int i = 0; i < 2; ++i) { int R, C; stage_rc(tid * 16 + i * 8192, R, C); const int Rb = Epi::PERM ? ((R & ~31) + perm32(R & 31)) : R;
        voffA[i] = (unsigned)(R * g.lda + C) * 2u; voffB[i] = (unsigned)(Rb * g.ldb + C) * 2u; }
    const size_t kstep = (size_t)(BK * 2);
    const size_t hA = (size_t)HALF * g.lda * 2, hB = (size_t)HALF * g.ldb * 2, tA = 2 * hA;
    const unsigned ldsw = (unsigned)wid * 1024u;
    const int aoff = lds_byte(wr * 64 + fr, fq * 8), boff = lds_byte(wc * 32 + fr, fq * 8);
#define PG8_SA(b, h) (((b) * 2 + (h)) * HTB)
#define PG8_SB(b, h) ((4 + (b) * 2 + (h)) * HTB)
#define PG8_STAGE(bufoff, gbase, voff) do { _Pragma("unroll") for (int _i = 0; _i < 2; ++_i) \
        __builtin_amdgcn_global_load_lds((const unsigned*)((const char*)(gbase) + (voff)[_i]), (LAS unsigned*)(lds + (bufoff) + ldsw + _i * 8192), 16, 0, 0); } while (0)
#define PG8_LDA(dst, b, h) do { _Pragma("unroll") for (int m = 0; m < 4; ++m) _Pragma("unroll") for (int k = 0; k < 2; ++k) dst[m][k] = *(const LAS bf16x8*)(lds + PG8_SA(b, h) + aoff + m * 2048 + k * 1024); } while (0)
#define PG8_LDB(dst, b, h) do { _Pragma("unroll") for (int n = 0; n < 2; ++n) _Pragma("unroll") for (int k = 0; k < 2; ++k) dst[n][k] = *(const LAS bf16x8*)(lds + PG8_SB(b, h) + boff + n * 2048 + k * 1024); } while (0)
#define PG8_MMA(ai, bj, At, Bt) do { __builtin_amdgcn_s_setprio(1); _Pragma("unroll") for (int m = 0; m < 4; ++m) _Pragma("unroll") for (int n = 0; n < 2; ++n) _Pragma("unroll") for (int k = 0; k < 2; ++k) \
        acc[ai][bj][m][n] = __builtin_amdgcn_mfma_f32_16x16x32_bf16(Bt[n][k], At[m][k], acc[ai][bj][m][n], 0, 0, 0); __builtin_amdgcn_s_setprio(0); } while (0)
#define PG8_WAIT_V(n) asm volatile("s_waitcnt vmcnt(" #n ")" ::: "memory")
#define PG8_WAIT_L(n) asm volatile("s_waitcnt lgkmcnt(" #n ")" ::: "memory")
#define PG8_BAR __builtin_amdgcn_s_barrier()
#define PG8_SCHED __builtin_amdgcn_sched_barrier(0)
#define PG8_ABASE(u) ((const char*)g.A + (size_t)((u).pm & g.am0) * tA + (size_t)(((u).pm >> g.ash) & g.am1) * g.sA)
#define PG8_BBASE(u) ((const char*)g.Bt + (size_t)((u).pn >> g.bsh) * g.sB1 + (size_t)((u).pn & g.bm0) * g.sB2 + (size_t)((u).pm >> g.ash) * g.sB)
    Unit cur, nxt; int ui = 0;
    if (!S.next(0, cur)) return;
    f32x4 acc[2][2][4][2];
#pragma unroll
    for (int a = 0; a < 2; ++a)
#pragma unroll
        for (int b = 0; b < 2; ++b)
#pragma unroll
            for (int m = 0; m < 4; ++m)
#pragma unroll
                for (int n = 0; n < 2; ++n) acc[a][b][m][n] = (f32x4){0.f, 0.f, 0.f, 0.f};
    bf16x8 At[4][2], B0[2][2], B1[2][2];
    const char* cA = PG8_ABASE(cur); const char* cB = PG8_BBASE(cur);
    if constexpr (SP2) {
        PG8_STAGE(PG8_SB(0, 0), cB, voffB); PG8_STAGE(PG8_SB(0, 1), cB + hB, voffB); PG8_STAGE(PG8_SA(0, 0), cA, voffA); PG8_STAGE(PG8_SA(0, 1), cA + hA, voffA);
        if (wr == 1) PG8_BAR;
        PG8_WAIT_V(2); PG8_BAR;
        PG8_STAGE(PG8_SB(1, 0), cB + kstep, voffB); PG8_STAGE(PG8_SA(1, 0), cA + kstep, voffA); PG8_STAGE(PG8_SB(1, 1), cB + hB + kstep, voffB);
        PG8_WAIT_V(6); PG8_BAR;
    } else {
        PG8_STAGE(PG8_SB(0, 0), cB, voffB); PG8_STAGE(PG8_SA(0, 0), cA, voffA); PG8_STAGE(PG8_SB(0, 1), cB + hB, voffB); PG8_STAGE(PG8_SA(0, 1), cA + hA, voffA);
        if (wr == 1) PG8_BAR;
        PG8_WAIT_V(4); PG8_BAR;
        PG8_STAGE(PG8_SB(1, 0), cB + kstep, voffB); PG8_STAGE(PG8_SA(1, 0), cA + kstep, voffA); PG8_STAGE(PG8_SB(1, 1), cB + hB + kstep, voffB);
        PG8_WAIT_V(6); PG8_BAR;
    }
    for (;;) {
        const bool has_next = S.next(ui + 1, nxt);
        const char* nA = has_next ? PG8_ABASE(nxt) : cA; const char* nB = has_next ? PG8_BBASE(nxt) : cB;
        for (int t = 0; t < nt; t += 2) {
            const bool last = (t == nt - 2);
            const char* a1 = cA + (size_t)(t + 1) * kstep;
            const char* a2 = last ? nA : cA + (size_t)(t + 2) * kstep; const char* b2 = last ? nB : cB + (size_t)(t + 2) * kstep;
            const char* a3 = a2 + kstep; const char* b3 = b2 + kstep;
            if constexpr (SP2) {
            PG8_LDB(B0, 0, 0); PG8_LDB(B1, 0, 1); PG8_SCHED; PG8_LDA(At, 0, 0); PG8_STAGE(PG8_SA(1, 1), a1 + hA, voffA);
            PG8_WAIT_V(8); PG8_WAIT_L(0); PG8_BAR; PG8_MMA(0, 0, At, B0); PG8_MMA(0, 1, At, B1); PG8_BAR; PG8_SCHED;
            PG8_LDA(At, 0, 1); PG8_STAGE(PG8_SB(0, 0), b2, voffB); PG8_STAGE(PG8_SB(0, 1), b2 + hB, voffB); PG8_STAGE(PG8_SA(0, 0), a2, voffA);
            PG8_WAIT_V(8); PG8_WAIT_L(0); PG8_BAR; PG8_MMA(1, 0, At, B0); PG8_MMA(1, 1, At, B1); PG8_BAR; PG8_SCHED;
            PG8_LDB(B0, 1, 0); PG8_LDB(B1, 1, 1); PG8_SCHED; PG8_LDA(At, 1, 0); PG8_STAGE(PG8_SA(0, 1), a2 + hA, voffA);
            PG8_WAIT_V(8); PG8_WAIT_L(0); PG8_BAR; PG8_MMA(0, 0, At, B0); PG8_MMA(0, 1, At, B1); PG8_BAR; PG8_SCHED;
            PG8_LDA(At, 1, 1); PG8_STAGE(PG8_SB(1, 0), b3, voffB); PG8_STAGE(PG8_SB(1, 1), b3 + hB, voffB); PG8_STAGE(PG8_SA(1, 0), a3, voffA);
            PG8_WAIT_V(8); PG8_WAIT_L(0); PG8_BAR; PG8_MMA(1, 0, At, B0); PG8_MMA(1, 1, At, B1); PG8_BAR; PG8_SCHED;
            } else {
            PG8_LDB(B0, 0, 0); PG8_SCHED; PG8_LDA(At, 0, 0); PG8_STAGE(PG8_SA(1, 1), a1 + hA, voffA);
            PG8_WAIT_L(8); PG8_BAR; PG8_WAIT_L(0); PG8_MMA(0, 0, At, B0); PG8_BAR; PG8_SCHED;
            PG8_LDB(B1, 0, 1); PG8_STAGE(PG8_SB(0, 0), b2, voffB);
            PG8_BAR; PG8_WAIT_L(0); PG8_MMA(0, 1, At, B1); PG8_BAR;
            PG8_LDA(At, 0, 1); PG8_STAGE(PG8_SA(0, 0), a2, voffA);
            PG8_BAR; PG8_WAIT_L(0); PG8_MMA(1, 0, At, B0); PG8_BAR; PG8_SCHED;
            PG8_STAGE(PG8_SB(0, 1), b2 + hB, voffB);
            PG8_WAIT_V(6); PG8_BAR; PG8_MMA(1, 1, At, B1); PG8_BAR;
            PG8_LDB(B0, 1, 0); PG8_SCHED; PG8_LDA(At, 1, 0); PG8_STAGE(PG8_SA(0, 1), a2 + hA, voffA);
            PG8_WAIT_L(8); PG8_BAR; PG8_WAIT_L(0); PG8_MMA(0, 0, At, B0); PG8_BAR; PG8_SCHED;
            PG8_LDB(B1, 1, 1); PG8_STAGE(PG8_SB(1, 0), b3, voffB);
            PG8_BAR; PG8_WAIT_L(0); PG8_MMA(0, 1, At, B1); PG8_BAR;
            PG8_LDA(At, 1, 1); PG8_STAGE(PG8_SA(1, 0), a3, voffA);
            PG8_BAR; PG8_WAIT_L(0); PG8_MMA(1, 0, At, B0); PG8_BAR; PG8_SCHED;
            PG8_STAGE(PG8_SB(1, 1), b3 + hB, voffB);
            PG8_WAIT_V(6); PG8_BAR; PG8_MMA(1, 1, At, B1); PG8_BAR;
            }
        }
        if constexpr (ALIGN_EPI) { if (wr == 0) PG8_BAR; }
        E(acc, cur, wr, wc, fr, fq);
        if (!has_next) break;
#pragma unroll
        for (int a = 0; a < 2; ++a)
#pragma unroll
            for (int b = 0; b < 2; ++b)
#pragma unroll
                for (int m = 0; m < 4; ++m)
#pragma unroll
                    for (int n = 0; n < 2; ++n) acc[a][b][m][n] = (f32x4){0.f, 0.f, 0.f, 0.f};
        cur = nxt; cA = nA; cB = nB; ++ui;
        if constexpr (ALIGN_EPI) { if (wr == 1) PG8_BAR; }
    }
    PG8_WAIT_V(0);
    if constexpr (!ALIGN_EPI) { if (wr == 0) PG8_BAR; }
    PG8_BAR;
#undef PG8_SA
#undef PG8_SB
#undef PG8_STAGE
#undef PG8_LDA
#undef PG8_LDB
#undef PG8_MMA
#undef PG8_WAIT_V
#undef PG8_WAIT_L
#undef PG8_BAR
#undef PG8_SCHED
#undef PG8_ABASE
#undef PG8_BBASE
}
}

namespace att {
constexpr int AD = 128, NW = 8, QBLK = 32, KVBLK = 64;
constexpr float SCALE = 0.088388347648318440f;
constexpr float THR = 8.f;
constexpr int LDQ = NQKV, LDK = NQKV, LDO = D;
constexpr size_t SHM_V = KVBLK * AD * 2, SHM_K = KVBLK * AD * 2, SHM_ATTN = 2 * SHM_V + 2 * SHM_K + NW * 64 * 4;
#define KSWZ(row, colB) ((row) * 256 + ((colB) ^ (((row) & 7) << 4)))
#define SBAR() __builtin_amdgcn_sched_barrier(0)
__device__ __forceinline__ int crow(int r, int hi) { return (r & 3) + 8 * (r >> 2) + 4 * hi; }
__device__ __forceinline__ unsigned cvtpk(float lo, float hi) { unsigned r; asm volatile("v_cvt_pk_bf16_f32 %0, %1, %2" : "=v"(r) : "v"(lo), "v"(hi)); return r; }
__device__ __forceinline__ void partialSM(f32x16& p0, f32x16& p1, float& m_reg, float& mn, float& alpha) {
  constexpr float C = SCALE * 1.4426950408889634f;
  float pmax = p0[0]; for (int r = 1; r < 16; ++r) pmax = fmaxf(pmax, p0[r]); for (int r = 0; r < 16; ++r) pmax = fmaxf(pmax, p1[r]);
  { auto rr = __builtin_amdgcn_permlane32_swap(__float_as_uint(pmax), __float_as_uint(pmax), false, false);
    pmax = fmaxf(__uint_as_float(rr[0]), __uint_as_float(rr[1])); }
  if (__builtin_expect(__all(pmax - m_reg <= THR / SCALE), 1)) { mn = m_reg; alpha = 1.f; }
  else { mn = fmaxf(m_reg, pmax); alpha = __builtin_amdgcn_exp2f((m_reg - mn) * C); m_reg = mn; }
  float mnC = -mn * C;
  for (int r = 0; r < 16; ++r) p0[r] = fmaf(p0[r], C, mnC); for (int r = 0; r < 16; ++r) p1[r] = fmaf(p1[r], C, mnC);
  for (int r = 0; r < 16; ++r) p0[r] = __builtin_amdgcn_exp2f(p0[r]);
}
__device__ __forceinline__ void finishSM(f32x16& p0, f32x16& p1, float alpha, float& l_reg, bf16x8& pa0, bf16x8& pa1, bf16x8& pa2, bf16x8& pa3) {
  for (int r = 0; r < 16; ++r) p1[r] = __builtin_amdgcn_exp2f(p1[r]);
  float ps = 0; for (int r = 0; r < 16; ++r) ps += p0[r]; for (int r = 0; r < 16; ++r) ps += p1[r];
  { auto rr = __builtin_amdgcn_permlane32_swap(__float_as_uint(ps), __float_as_uint(ps), false, false);
    ps = __uint_as_float(rr[0]) + __uint_as_float(rr[1]); }
  l_reg = l_reg * alpha + ps;
#define PK4(P, BASE, OUT) do { unsigned a0 = cvtpk(P[BASE + 0], P[BASE + 1]), a1 = cvtpk(P[BASE + 2], P[BASE + 3]);   \
    unsigned b0 = cvtpk(P[BASE + 4], P[BASE + 5]), b1 = cvtpk(P[BASE + 6], P[BASE + 7]);                              \
    auto r0 = __builtin_amdgcn_permlane32_swap(a0, b0, false, false); auto r1 = __builtin_amdgcn_permlane32_swap(a1, b1, false, false); \
    u32x4 w = {r0[0], r1[0], r0[1], r1[1]}; OUT = *reinterpret_cast<bf16x8*>(&w); } while (0)
  PK4(p0, 0, pa0); PK4(p0, 8, pa1); PK4(p1, 0, pa2); PK4(p1, 8, pa3);
#undef PK4
}
__device__ __forceinline__ void qkt(f32x16& p0, f32x16& p1, const bf16_t* Ks, const bf16x8* qr, int r32, int hi) {
  p0 = f32x16{}; p1 = f32x16{};
  for (int d0 = 0; d0 < 8; ++d0) { int cb = (d0 * 16 + hi * 8) * 2;
    bf16x8 b0 = *reinterpret_cast<const bf16x8*>((const char*)Ks + KSWZ(r32, cb));
    bf16x8 b1 = *reinterpret_cast<const bf16x8*>((const char*)Ks + KSWZ(32 + r32, cb));
    p0 = __builtin_amdgcn_mfma_f32_32x32x16_bf16(b0, qr[d0], p0, 0, 0, 0);
    p1 = __builtin_amdgcn_mfma_f32_32x32x16_bf16(b1, qr[d0], p1, 0, 0, 0); }
}
__device__ __forceinline__ int v_st(int k, int c) { const int kk = (k & ~0xC) | ((k & 4) << 1) | ((k & 8) >> 1); return ((kk >> 3) * 4 + (c >> 5)) * 512 + ((kk & 7) * 32 + (c & 31)) * 2; }
__device__ __forceinline__ int v_rd_base(int lane) { return ((lane & 3) << 3) | (((lane >> 2) & 3) << 6) | (((lane >> 4) & 1) << 5) | (((lane >> 5) & 1) << 8); }
constexpr int v_rd_off(int d0, int ks, int half) { return d0 * 512 + ks * 4096 + half * 2048; }
template <int OFF> __device__ __forceinline__ s16x4 tr_read(int vb) {
  s16x4 r; asm volatile("ds_read_b64_tr_b16 %0, %1 offset:%2" : "=&v"(r) : "v"(vb), "i"(OFF) : "memory"); return r;
}
template <int D0> __device__ __forceinline__ void pv_one(f32x16& od, int vb, bf16x8 pa0, bf16x8 pa1, bf16x8 pa2, bf16x8 pa3) {
  const s16x4 l0 = tr_read<v_rd_off(D0, 0, 0)>(vb), h0 = tr_read<v_rd_off(D0, 0, 1)>(vb), l1 = tr_read<v_rd_off(D0, 1, 0)>(vb), h1 = tr_read<v_rd_off(D0, 1, 1)>(vb);
  const s16x4 l2 = tr_read<v_rd_off(D0, 2, 0)>(vb), h2 = tr_read<v_rd_off(D0, 2, 1)>(vb), l3 = tr_read<v_rd_off(D0, 3, 0)>(vb), h3 = tr_read<v_rd_off(D0, 3, 1)>(vb);
  asm volatile("s_waitcnt lgkmcnt(0)" ::: "memory"); SBAR();
#define PK(L, H) (bf16x8){L[0], L[1], L[2], L[3], H[0], H[1], H[2], H[3]}
  od = __builtin_amdgcn_mfma_f32_32x32x16_bf16(pa0, PK(l0, h0), od, 0, 0, 0);
  od = __builtin_amdgcn_mfma_f32_32x32x16_bf16(pa1, PK(l1, h1), od, 0, 0, 0);
  od = __builtin_amdgcn_mfma_f32_32x32x16_bf16(pa2, PK(l2, h2), od, 0, 0, 0);
  od = __builtin_amdgcn_mfma_f32_32x32x16_bf16(pa3, PK(l3, h3), od, 0, 0, 0);
#undef PK
}
__device__ __forceinline__ void pv_d0(f32x16* o, int vb, bf16x8 pa0, bf16x8 pa1, bf16x8 pa2, bf16x8 pa3) {
  pv_one<0>(o[0], vb, pa0, pa1, pa2, pa3); pv_one<1>(o[1], vb, pa0, pa1, pa2, pa3); pv_one<2>(o[2], vb, pa0, pa1, pa2, pa3); pv_one<3>(o[3], vb, pa0, pa1, pa2, pa3);
}
__device__ __forceinline__ void attn_dense_body(const bf16_t* __restrict__ Qb, const bf16_t* __restrict__ Kh, const bf16_t* __restrict__ Vh,
                                                bf16_t* __restrict__ Ob, int seq, char* lds) {
  constexpr int SDEPTH = 2;
  const int tid = tid_opaque(), wid = tid >> 6, lane = tid & 63, r32 = lane & 31, hi = lane >> 5;
  bf16_t* V_lds = (bf16_t*)lds; bf16_t* K_lds = (bf16_t*)(lds + 2 * SHM_V);
  float* ws = (float*)(lds + 2 * SHM_V + 2 * SHM_K) + wid * 64; float* li_l = ws; float* al_l = ws + 32;
  float m_reg = -1e30f, l_reg = 0; f32x16 o[4] = {}; bf16x8 qr[8];
  const bf16_t* Qw = Qb + (long)(wid * QBLK + r32) * LDQ + hi * 8;
#pragma unroll
  for (int d0 = 0; d0 < 8; ++d0) qr[d0] = *reinterpret_cast<const bf16x8*>(Qw + d0 * 16);
  const int sr = tid >> 4, sc = (tid & 15) * 8, vst0 = v_st(sr, sc), vst1 = v_st(32 + sr, sc);
  const int vb0 = (int)(uintptr_t)V_lds + v_rd_base(lane);
  struct { bf16x8 vs0, vs1, ks0, ks1; } sr_[SDEPTH];
#define SLOAD(i, k0) do { sr_[i].vs0 = *reinterpret_cast<const bf16x8*>(&Vh[(long)((k0) + sr) * LDK + sc]); sr_[i].vs1 = *reinterpret_cast<const bf16x8*>(&Vh[(long)((k0) + 32 + sr) * LDK + sc]); \
    sr_[i].ks0 = *reinterpret_cast<const bf16x8*>(&Kh[(long)((k0) + sr) * LDK + sc]); sr_[i].ks1 = *reinterpret_cast<const bf16x8*>(&Kh[(long)((k0) + 32 + sr) * LDK + sc]); } while (0)
#define SWRITE(b, i) do { *(bf16x8*)((char*)V_lds + (b) * SHM_V + vst0) = sr_[i].vs0;          \
    *(bf16x8*)((char*)V_lds + (b) * SHM_V + vst1) = sr_[i].vs1; int kc = sc * 2;               \
    *(bf16x8*)((char*)K_lds + (b) * SHM_K + KSWZ(sr, kc)) = sr_[i].ks0;                       \
    *(bf16x8*)((char*)K_lds + (b) * SHM_K + KSWZ(32 + sr, kc)) = sr_[i].ks1; } while (0)
#define SWAIT() do { asm volatile("s_waitcnt vmcnt(4)" ::: "memory"); } while (0)
#define RESC(a) do { if (__any((a) < 1.f)) { if (hi == 0) al_l[r32] = (a); asm volatile("s_waitcnt lgkmcnt(0)" ::: "memory"); \
    for (int d = 0; d < 4; ++d) for (int r = 0; r < 16; ++r) o[d][r] *= al_l[crow(r, hi)]; } } while (0)
  f32x16 pA0, pA1, pB0, pB1; float mnA, mnB, alA, alB; bf16x8 pa0, pa1, pa2, pa3; const int NT = seq / KVBLK;
  constexpr int SE = 0, SO = SDEPTH - 1;
  SLOAD(SE, 0); asm volatile("s_waitcnt vmcnt(0)" ::: "memory"); SWRITE(0, SE); __syncthreads();
  qkt(pA0, pA1, K_lds, qr, r32, hi); partialSM(pA0, pA1, m_reg, mnA, alA);
  SLOAD(SO, KVBLK); if (2 < NT) SLOAD(SE, 2 * KVBLK);
  SWAIT(); SWRITE(1, SO); __syncthreads();
  for (int j = 1; j + 1 < NT; j += 2) {
    SBAR(); qkt(pB0, pB1, (bf16_t*)((char*)K_lds + SHM_K), qr, r32, hi);
    finishSM(pA0, pA1, alA, l_reg, pa0, pa1, pa2, pa3); SBAR();
    SLOAD(SO, (j + SDEPTH) * KVBLK); SBAR();
    pv_d0(o, vb0, pa0, pa1, pa2, pa3); partialSM(pB0, pB1, m_reg, mnB, alB);
    __syncthreads(); SWAIT(); SWRITE(0, SE);
    RESC(alB); __syncthreads();
    SBAR(); qkt(pA0, pA1, K_lds, qr, r32, hi);
    finishSM(pB0, pB1, alB, l_reg, pa0, pa1, pa2, pa3); SBAR();
    if (j + 3 < NT) SLOAD(SE, (j + 1 + SDEPTH) * KVBLK); SBAR();
    pv_d0(o, vb0 + (int)SHM_V, pa0, pa1, pa2, pa3); partialSM(pA0, pA1, m_reg, mnA, alA);
    __syncthreads(); SWAIT(); SWRITE(1, SO);
    RESC(alA); __syncthreads();
  }
  SBAR(); qkt(pB0, pB1, (bf16_t*)((char*)K_lds + SHM_K), qr, r32, hi);
  finishSM(pA0, pA1, alA, l_reg, pa0, pa1, pa2, pa3); SBAR();
  pv_d0(o, vb0, pa0, pa1, pa2, pa3); partialSM(pB0, pB1, m_reg, mnB, alB);
  __syncthreads(); RESC(alB);
  finishSM(pB0, pB1, alB, l_reg, pa0, pa1, pa2, pa3); SBAR();
  pv_d0(o, vb0 + (int)SHM_V, pa0, pa1, pa2, pa3);
  if (hi == 0) li_l[r32] = l_reg; asm volatile("s_waitcnt lgkmcnt(0)" ::: "memory");
  float rli[16];
#pragma unroll
  for (int r = 0; r < 16; ++r) rli[r] = __builtin_amdgcn_rcpf(li_l[crow(r, hi)]);
  bf16_t* Ow = Ob + (long)(wid * QBLK) * LDO;
#pragma unroll
  for (int r = 0; r < 16; ++r) { int orow = crow(r, hi);
    for (int d0 = 0; d0 < 4; ++d0) Ow[(long)orow * LDO + d0 * 32 + r32] = (bf16_t)f2bf(o[d0][r] * rli[r]); }
  asm volatile("s_waitcnt vmcnt(0) lgkmcnt(0)" ::: "memory");
  __syncthreads();
#undef SLOAD
#undef SWRITE
#undef SWAIT
#undef RESC
}
}

struct Params;
typedef const __attribute__((address_space(4))) Params& KPR;
struct Params {
    const float* x_prompt; const float* x_sample; const float* c_prompt; const float* c_sample;
    const float* norm1_g; const float* norm2_g; const float* w_ada; const float* b_ada;
    const float* fnet_w_o; const float* attn_w_qkv; const float* attn_q_g; const float* attn_k_g; const float* attn_w_o;
    const float* sgu_w_in; const float* sgu_ln_g; const float* sgu_ln_b; const float* sgu_w_s; const float* sgu_b_s; const float* sgu_w_o;
    const float* ffn_w_gu; const float* ffn_w_down; const float* final_g;
    float* out; unsigned char* ws;
    int ph_lo, ph_hi;
};

enum { K_PREP = 0, K_NORM, K_CHANDFT, K_SEQDFT, K_RESID, K_GU, K_QKV, K_QKROPE, K_ATTN, K_WIN, K_SGU, K_FINAL, K_FFT2 };
struct PhaseDesc { unsigned char kind, layer, aux; };
constexpr int NPH = 33;
__device__ const PhaseDesc PHASES[NPH] = {
    {K_PREP, 0, 0},
    {K_NORM, 0, 0}, {K_CHANDFT, 0, 0}, {K_SEQDFT, 0, 0}, {K_FFT2, 0, 0}, {K_RESID, 0, 0}, {K_NORM, 0, 1}, {K_GU, 0, 0}, {K_RESID, 0, 4},
    {K_NORM, 1, 0}, {K_QKV, 1, 0}, {K_QKROPE, 1, 0}, {K_ATTN, 1, 0}, {K_RESID, 1, 2}, {K_NORM, 1, 1}, {K_GU, 1, 0}, {K_RESID, 1, 4},
    {K_NORM, 2, 0}, {K_WIN, 2, 0}, {K_SGU, 2, 0}, {K_RESID, 2, 3}, {K_NORM, 2, 1}, {K_GU, 2, 0}, {K_RESID, 2, 4},
    {K_NORM, 3, 0}, {K_CHANDFT, 3, 0}, {K_SEQDFT, 3, 0}, {K_FFT2, 3, 0}, {K_RESID, 3, 1}, {K_NORM, 3, 1}, {K_GU, 3, 0}, {K_RESID, 3, 4},
    {K_FINAL, 0, 0}};

__device__ __forceinline__ void transpose_item(const float* W, int K, int N, bf16_t* WT, int gu, LAS float* scr, int item, int lane) {
    const int nblk = N / 32, kb = item / nblk, nb = item % nblk, k0 = 64 * kb, n0 = 32 * nb;
#pragma unroll 8
    for (int i = 0; i < 32; ++i) { const int kk = 2 * i + (lane >> 5); scr[kk * 33 + (lane & 31)] = W[(size_t)(k0 + kk) * N + n0 + (lane & 31)]; }
    LDS_WAIT(); asm volatile("" ::: "memory");
    int d0 = n0;
    if (gu) { const int half = n0 / FF, j = n0 - half * FF; d0 = 256 * (j / 128) + 128 * half + (j % 128); }
    const int c = lane & 7;
#pragma unroll
    for (int j = 0; j < 4; ++j) { const int n = (lane >> 3) + 8 * j; const LAS float* s = scr + (8 * c) * 33 + n;
        u32x4 o; o.x = pk2(s[0 * 33], s[1 * 33]); o.y = pk2(s[2 * 33], s[3 * 33]); o.z = pk2(s[4 * 33], s[5 * 33]); o.w = pk2(s[6 * 33], s[7 * 33]);
        *(u32x4*)(WT + (size_t)(d0 + n) * K + k0 + 8 * c) = o; }
    LDS_WAIT(); asm volatile("" ::: "memory");
}

__device__ __forceinline__ void phase_prep(KPR p, LAS unsigned char* lds, int G) {
    const int tid = tid_opaque(), lane = tid & 63, wave = tid >> 6;
    unsigned char* ws = p.ws;
    for (int item = blockIdx.x; item < 4 * 48; item += G) {
        const int layer = item / 48, col0 = (item % 48) * 128;
        LAS float* csT = (LAS float*)lds;
        for (int idx = tid; idx < 32 * 1024; idx += NTHR) { const int b = idx >> 10, k = idx & 1023;
            const float c = b < 16 ? p.c_prompt[b * 1024 + k] : p.c_sample[(b - 16) * 1024 + k];
            csT[k * 32 + b] = c / (1.0f + __expf(-c)); }
        __syncthreads();
        float acc[32][2];
#pragma unroll
        for (int b = 0; b < 32; ++b) { acc[b][0] = 0.f; acc[b][1] = 0.f; }
        const float* wp = p.w_ada + ((size_t)layer * 1024 + wave * 128) * NMOD + col0 + 2 * lane;
#pragma unroll 4
        for (int kk = 0; kk < 128; ++kk) { const f32x2 wv = *(const f32x2*)(wp + (size_t)kk * NMOD); const LAS float* cr = csT + (wave * 128 + kk) * 32;
#pragma unroll
            for (int b = 0; b < 32; ++b) { const float cv = cr[b]; acc[b][0] += cv * wv.x; acc[b][1] += cv * wv.y; } }
        __syncthreads();
        LAS float* part = (LAS float*)lds;
#pragma unroll
        for (int b = 0; b < 32; ++b) *(LAS f32x2*)(part + (wave * 32 + b) * 128 + 2 * lane) = (f32x2){acc[b][0], acc[b][1]};
        __syncthreads();
        for (int o = tid; o < 32 * 128; o += NTHR) { const int b = o >> 7, cc = o & 127; float s = p.b_ada[layer * NMOD + col0 + cc];
#pragma unroll
            for (int w = 0; w < 8; ++w) s += part[(w * 32 + b) * 128 + cc];
            ((float*)(ws + WS_MOD))[((size_t)layer * 32 + b) * NMOD + col0 + cc] = s; }
        __syncthreads();
    }
    __syncthreads();
    {
        LAS float* scr = (LAS float*)(lds + wave * 16384);
        const int gw = blockIdx.x * NWAVES + wave, NGW = G * NWAVES;
        constexpr int I_SQ = (D / 64) * (D / 32), I_QKV = (D / 64) * (NQKV / 32), I_WIN = (D / 64) * (2048 / 32), I_GU = (D / 64) * (2 * FF / 32), I_DN = (FF / 64) * (D / 32);
        constexpr int NITEMS = 4 * I_SQ + I_QKV + I_WIN + 4 * I_GU + 4 * I_DN;
        for (int it = gw; it < NITEMS; it += NGW) {
            int r = it;
            if (r < 2 * I_SQ) { const int j = r / I_SQ; transpose_item(p.fnet_w_o + (size_t)j * D * D, D, D, (bf16_t*)(ws + WS_FNETW) + (size_t)j * D * D, 0, scr, r % I_SQ, lane); continue; } r -= 2 * I_SQ;
            if (r < I_SQ) { transpose_item(p.attn_w_o, D, D, (bf16_t*)(ws + WS_WAO), 0, scr, r, lane); continue; } r -= I_SQ;
            if (r < I_SQ) { transpose_item(p.sgu_w_o, D, D, (bf16_t*)(ws + WS_WSO), 0, scr, r, lane); continue; } r -= I_SQ;
            if (r < I_QKV) { transpose_item(p.attn_w_qkv, D, NQKV, (bf16_t*)(ws + WS_WQKV), 0, scr, r, lane); continue; } r -= I_QKV;
            if (r < I_WIN) { transpose_item(p.sgu_w_in, D, 2048, (bf16_t*)(ws + WS_WIN), 0, scr, r, lane); continue; } r -= I_WIN;
            if (r < 4 * I_GU) { const int j = r / I_GU; transpose_item(p.ffn_w_gu + (size_t)j * D * 2 * FF, D, 2 * FF, (bf16_t*)(ws + WS_WGU) + (size_t)j * D * 2 * FF, 1, scr, r % I_GU, lane); continue; } r -= 4 * I_GU;
            { const int j = r / I_DN; transpose_item(p.ffn_w_down + (size_t)j * FF * D, FF, D, (bf16_t*)(ws + WS_WDN) + (size_t)j * FF * D, 0, scr, r % I_DN, lane); }
        }
    }
    const size_t gt = (size_t)blockIdx.x * NTHR + tid, NGT = (size_t)G * NTHR;
    for (size_t i = gt; i < 8 * 128 * 128; i += NGT) ((bf16_t*)(ws + WS_WSB))[i] = (bf16_t)f2bf(p.sgu_w_s[i]);
    for (size_t i = gt; i < 512 * 256; i += NGT) { const int m = (int)(i >> 8), c = (int)(i & 255), l = m & 255; const float a = (float)((l * c) & 255) * (1.0f / 128.0f);
        ((bf16_t*)(ws + WS_DFTC))[i] = (bf16_t)f2bf(m < 256 ? cospif(a) : sinpif(a)); }
    for (int part = 0; part < 2; ++part) {
        const int L = part ? 8 : 16, S_ = part ? SS : SP; bf16_t* M1 = (bf16_t*)(ws + (part ? WS_M1S : WS_M1P)); const float inv = 2.0f / (float)S_;
        for (size_t i = gt; i < (size_t)L * 512 * 512 / 8; i += NGT) { const int s_lo = (int)(i >> 15), m = (int)(i >> 6) & 511, j0 = (int)(i & 63) * 8, ri = m >> 8, k_lo = m & 255; float v[8];
#pragma unroll
            for (int e = 0; e < 8; ++e) { const int j = j0 + e, cs = j >> 8, s_hi = j & 255; const float a = (float)((k_lo * (s_lo + L * s_hi)) & (S_ - 1)) * inv;
                const float cv = cospif(a), sv = sinpif(a); v[e] = ri == 0 ? (cs == 0 ? cv : -sv) : (cs == 0 ? sv : cv); }
            u32x4 o; o.x = pk2(v[0], v[1]); o.y = pk2(v[2], v[3]); o.z = pk2(v[4], v[5]); o.w = pk2(v[6], v[7]);
            *(u32x4*)(M1 + i * 8) = o; }
    }
}

template <int L> __device__ __forceinline__ void fft2_part(const bf16_t* Y, bf16_t* F, float scale, int G, int tid) {
    constexpr float C16[16] = {1.0f, 0.92387953251f, 0.70710678119f, 0.38268343237f, 0.0f, -0.38268343237f, -0.70710678119f, -0.92387953251f, -1.0f, -0.92387953251f, -0.70710678119f, -0.38268343237f, 0.0f, 0.38268343237f, 0.70710678119f, 0.92387953251f};
    constexpr float S16[16] = {0.0f, 0.38268343237f, 0.70710678119f, 0.92387953251f, 1.0f, 0.92387953251f, 0.70710678119f, 0.38268343237f, 0.0f, -0.38268343237f, -0.70710678119f, -0.92387953251f, -1.0f, -0.92387953251f, -0.70710678119f, -0.38268343237f};
    constexpr int LSH = (L == 16) ? 4 : 3, SLEN = 256 * L;
    for (unsigned id = blockIdx.x * NTHR + tid; id < 16u * 256u * 256u; id += (unsigned)G * NTHR) {
        const unsigned chq = id & 255u, k_lo = (id >> 8) & 255u, b = id >> 16;
        float yr[L][4], yi[L][4];
#pragma unroll
        for (int sl = 0; sl < L; ++sl) { const bf16_t* yp = Y + ((size_t)(((b << LSH) + sl) * 512u + k_lo)) * 1024 + 4 * chq;
            const u32x2 a = *(const u32x2*)yp, c = *(const u32x2*)(yp + 256 * 1024);
            yr[sl][0] = __builtin_bit_cast(float, a.x << 16); yr[sl][1] = __builtin_bit_cast(float, a.x & 0xffff0000u); yr[sl][2] = __builtin_bit_cast(float, a.y << 16); yr[sl][3] = __builtin_bit_cast(float, a.y & 0xffff0000u);
            yi[sl][0] = __builtin_bit_cast(float, c.x << 16); yi[sl][1] = __builtin_bit_cast(float, c.x & 0xffff0000u); yi[sl][2] = __builtin_bit_cast(float, c.y << 16); yi[sl][3] = __builtin_bit_cast(float, c.y & 0xffff0000u); }
#pragma unroll
        for (int kh = 0; kh < L; ++kh) { float acc[4] = {0.f, 0.f, 0.f, 0.f};
#pragma unroll
            for (int sl = 0; sl < L; ++sl) { const int t = ((kh * sl) % L) * (16 / L); const float cv = C16[t], sv = S16[t];
#pragma unroll
                for (int e = 0; e < 4; ++e) acc[e] += cv * yr[sl][e] - sv * yi[sl][e]; }
            u32x2 w; w.x = pk2(acc[0] * scale, acc[1] * scale); w.y = pk2(acc[2] * scale, acc[3] * scale);
            *(u32x2*)(F + ((size_t)(b * SLEN + k_lo + 256 * kh)) * 1024 + 4 * chq) = w; }
    }
}
__device__ __forceinline__ void phase_fft2(KPR p, int G) {
    const int tid = tid_opaque();
    fft2_part<16>((const bf16_t*)(p.ws + WS_Y), (bf16_t*)(p.ws + WS_ZT), 0.015625f, G, tid);
    fft2_part<8>((const bf16_t*)(p.ws + WS_Y) + (size_t)TP * 2048, (bf16_t*)(p.ws + WS_ZT) + (size_t)TP * D, 0.022097086912079608f, G, tid);
}

__device__ __forceinline__ void phase_norm(KPR p, int layer, int which, int G) {
    const int tid = tid_opaque(), lane = tid & 63, wave = tid >> 6;
    const bool first = (layer == 0 && which == 0);
    const float* gam = (which ? p.norm2_g : p.norm1_g) + layer * D;
    const float* mod = (const float*)(p.ws + WS_MOD) + (size_t)layer * 32 * NMOD + (which ? 3 : 0) * D;
    bf16_t* H = (bf16_t*)(p.ws + WS_H);
    f32x4 gv[4];
#pragma unroll
    for (int j = 0; j < 4; ++j) gv[j] = *(const f32x4*)(gam + 4 * (lane + 64 * j));
    for (int row = blockIdx.x * NWAVES + wave; row < T; row += G * NWAVES) {
        const float* xr = first ? (row < TP ? p.x_prompt + (size_t)row * D : p.x_sample + (size_t)(row - TP) * D) : p.out + (size_t)row * D;
        f32x4 v[4]; float s = 0.f;
#pragma unroll
        for (int j = 0; j < 4; ++j) { v[j] = *(const f32x4*)(xr + 4 * (lane + 64 * j)); s += (v[j].x * v[j].x + v[j].y * v[j].y) + (v[j].z * v[j].z + v[j].w * v[j].w); }
        const float rstd = rsqrtf(wave_sum(s) * (1.0f / D) + EPS);
        const float* mr = mod + (size_t)seq_of(row) * NMOD;
#pragma unroll
        for (int j = 0; j < 4; ++j) { const int c = 4 * (lane + 64 * j); const f32x4 sh = *(const f32x4*)(mr + c), sc = *(const f32x4*)(mr + D + c);
            const f32x4 y = (v[j] * rstd) * gv[j]; const f32x4 h = y * (sc + 1.0f) + sh;
            u32x2 w; w.x = pk2(h.x, h.y); w.y = pk2(h.z, h.w);
            *(u32x2*)(H + (size_t)row * D + c) = w; }
    }
}

__device__ __forceinline__ void phase_final(KPR p, int G) {
    const int tid = tid_opaque(), lane = tid & 63, wave = tid >> 6;
    f32x4 gv[4];
#pragma unroll
    for (int j = 0; j < 4; ++j) gv[j] = *(const f32x4*)(p.final_g + 4 * (lane + 64 * j));
    for (int row = blockIdx.x * NWAVES + wave; row < T; row += G * NWAVES) {
        float* xr = p.out + (size_t)row * D;
        f32x4 v[4]; float s = 0.f;
#pragma unroll
        for (int j = 0; j < 4; ++j) { v[j] = *(const f32x4*)(xr + 4 * (lane + 64 * j)); s += (v[j].x * v[j].x + v[j].y * v[j].y) + (v[j].z * v[j].z + v[j].w * v[j].w); }
        const float rstd = rsqrtf(wave_sum(s) * (1.0f / D) + EPS);
#pragma unroll
        for (int j = 0; j < 4; ++j) *(f32x4*)(xr + 4 * (lane + 64 * j)) = (v[j] * rstd) * gv[j];
    }
}

__device__ __forceinline__ void phase_qkrope(KPR p, int G) {
    const int tid = tid_opaque(), lane = tid & 63, wave = tid >> 6;
    bf16_t* QKVb = (bf16_t*)(p.ws + WS_BIG);
    const int i0 = 2 * (lane & 15);
    const float f0 = 1.0f / powf(10000.0f, (float)(2 * i0) / 64.0f), f1 = 1.0f / powf(10000.0f, (float)(2 * (i0 + 1)) / 64.0f);
    const bool x2 = (lane & 31) >= 16, colhalf = lane >= 32;
    const f32x2 qg = *(const f32x2*)(p.attn_q_g + 2 * lane), kg = *(const f32x2*)(p.attn_k_g + 2 * lane);
    for (int row = blockIdx.x * NWAVES + wave; row < T; row += G * NWAVES) {
        const int sq = seq_of(row), t = row - seq_start(sq);
        const float pos = (float)(colhalf ? (t & 63) : (t >> 6));
        float s0, c0, s1, c1; sincosf(pos * f0, &s0, &c0); sincosf(pos * f1, &s1, &c1);
        unsigned* rp = (unsigned*)(QKVb + (size_t)row * NQKV) + lane;
        unsigned raw[10];
#pragma unroll
        for (int h = 0; h < 10; ++h) raw[h] = rp[h * 64];
#pragma unroll
        for (int h = 0; h < 10; ++h) {
            const float v0 = bf2f((unsigned short)(raw[h] & 0xffffu)), v1 = bf2f((unsigned short)(raw[h] >> 16));
            const float rstd = rsqrtf(wave_sum(v0 * v0 + v1 * v1) * (1.0f / 128.0f) + EPS);
            const f32x2 g = h < 8 ? qg : kg;
            const float y0 = v0 * rstd * g.x, y1 = v1 * rstd * g.y;
            const float z0 = __shfl_xor(y0, 16), z1 = __shfl_xor(y1, 16);
            const float o0 = x2 ? (y0 * c0 + z0 * s0) : (y0 * c0 - z0 * s0);
            const float o1 = x2 ? (y1 * c1 + z1 * s1) : (y1 * c1 - z1 * s1);
            rp[h * 64] = pk2(o0, o1);
        }
    }
}

__device__ __forceinline__ void phase_attn(KPR p, char* lds, int G) {
    const bf16_t* QKVb = (const bf16_t*)(p.ws + WS_BIG); bf16_t* O = (bf16_t*)(p.ws + WS_H);
    const int bx = blockIdx.x, vcu = (G % 8 == 0) ? (bx % 8) * (G / 8) + bx / 8 : bx;
    for (int u = vcu; u < 2048 + 1024; u += G) {
        int b, kvh, g, qb, S;
        if (u < 2048) { b = u >> 7; const int r = u & 127; kvh = r >> 6; g = (r >> 4) & 3; qb = r & 15; S = SP; }
        else { const int v = u - 2048; b = 16 + (v >> 6); const int r = v & 63; kvh = r >> 5; g = (r >> 3) & 3; qb = r & 7; S = SS; }
        const int h = kvh * 4 + g; const size_t r0 = (size_t)seq_start(b);
        att::attn_dense_body(QKVb + (r0 + (size_t)qb * 256) * NQKV + h * 128, QKVb + r0 * NQKV + 1024 + kvh * 128, QKVb + r0 * NQKV + 1280 + kvh * 128,
                             O + (r0 + (size_t)qb * 256) * D + h * 128, S, lds);
    }
}

__device__ __forceinline__ void phase_sgu(KPR p, char* lds, int G) {
    const int tid = tid_opaque(), lane = tid & 63, wave = tid >> 6, r32 = lane & 31, hi = lane >> 5;
    const bf16_t* UV = (const bf16_t*)(p.ws + WS_BIG); bf16_t* OUT = (bf16_t*)(p.ws + WS_H); const bf16_t* WSB = (const bf16_t*)(p.ws + WS_WSB);
    constexpr int VS = 136;
    bf16_t* VT = (bf16_t*)lds;
    float* st = (float*)(lds + 128 * VS * 2);
    for (int ci = blockIdx.x; ci < T / 128; ci += G) {
        const size_t r0 = (size_t)ci * 128;
        for (int rr = 0; rr < 16; ++rr) { const int j = wave * 16 + rr; const bf16_t* vp = UV + (r0 + j) * 2048 + 1024 + 8 * lane;
            const bf16x8 a = *(const bf16x8*)vp, b = *(const bf16x8*)(vp + 512); float x[16]; float s = 0.f;
#pragma unroll
            for (int e = 0; e < 8; ++e) { x[e] = bf2f((unsigned short)a[e]); x[8 + e] = bf2f((unsigned short)b[e]); }
#pragma unroll
            for (int e = 0; e < 16; ++e) s += x[e];
            const float mean = wave_sum(s) * (1.0f / 1024.0f); float q = 0.f;
#pragma unroll
            for (int e = 0; e < 16; ++e) { const float d = x[e] - mean; q += d * d; }
            const float rstd = rsqrtf(wave_sum(q) * (1.0f / 1024.0f) + EPS);
            if (lane == 0) { st[2 * j] = mean; st[2 * j + 1] = rstd; } }
        __syncthreads();
        for (int g = 0; g < 8; ++g) {
            { const int j = tid & 127; const float mean = st[2 * j], rstd = st[2 * j + 1];
#pragma unroll
              for (int it = 0; it < 4; ++it) { const int c0 = 8 * ((tid >> 7) + 4 * it);
                const bf16x8 a = *(const bf16x8*)(UV + (r0 + j) * 2048 + 1024 + g * 128 + c0);
#pragma unroll
                for (int e = 0; e < 8; ++e) { const int c = c0 + e; const float vn = (bf2f((unsigned short)a[e]) - mean) * rstd * p.sgu_ln_g[g * 128 + c] + p.sgu_ln_b[g * 128 + c];
                    VT[c * VS + j] = (bf16_t)f2bf(vn); } } }
            __syncthreads();
            const int it_ = wave >> 1, ct0 = (wave & 1) * 2;
            f32x16 acc0 = {}, acc1 = {};
            const bf16_t* ap = WSB + (size_t)g * 16384 + (32 * it_ + r32) * 128 + 8 * hi;
#pragma unroll
            for (int ks = 0; ks < 8; ++ks) {
                const bf16x8 af = *(const bf16x8*)(ap + 16 * ks);
                const bf16x8 b0 = *(const bf16x8*)(VT + (32 * ct0 + r32) * VS + 16 * ks + 8 * hi);
                const bf16x8 b1 = *(const bf16x8*)(VT + (32 * (ct0 + 1) + r32) * VS + 16 * ks + 8 * hi);
                acc0 = __builtin_amdgcn_mfma_f32_32x32x16_bf16(af, b0, acc0, 0, 0, 0);
                acc1 = __builtin_amdgcn_mfma_f32_32x32x16_bf16(af, b1, acc1, 0, 0, 0);
            }
#pragma unroll
            for (int r = 0; r < 16; ++r) { const int i = 32 * it_ + att::crow(r, hi); const float bs = p.sgu_b_s[g * 128 + i];
                const size_t ro = r0 + i; const int c_0 = g * 128 + 32 * ct0 + r32, c_1 = c_0 + 32;
                const float u0 = bf2f(UV[ro * 2048 + c_0]), u1 = bf2f(UV[ro * 2048 + c_1]);
                OUT[ro * D + c_0] = (bf16_t)f2bf(u0 * (acc0[r] + bs)); OUT[ro * D + c_1] = (bf16_t)f2bf(u1 * (acc1[r] + bs)); }
            __syncthreads();
        }
    }
}

#define XB_TMO      128
#define XB_XCNT(j)  (256  + 64 * (j))
#define XB_XSUB(j)  (1280 + 64 * (j))
#define XB_XGEN(j)  (2304 + 64 * (j))
#define XB_TOP      3328
#define XB_TOPGEN   3392
#define XCD_BAR_WORDS 3456
#define XB_SPIN_CAP (1u << 22)
__device__ __forceinline__ unsigned xb_ld(unsigned* p)              { return __hip_atomic_load(p, __ATOMIC_RELAXED, __HIP_MEMORY_SCOPE_AGENT); }
__device__ __forceinline__ unsigned xb_add(unsigned* p, unsigned v) { return __hip_atomic_fetch_add(p, v, __ATOMIC_RELAXED, __HIP_MEMORY_SCOPE_AGENT); }
__device__ __forceinline__ unsigned xb_xcc_id() { return (unsigned)__builtin_amdgcn_s_getreg((3 << 11) | 20) & 0xFu; }
#define XB_SPIN(cond, bar) do { unsigned _sp = 0; while (cond) { __builtin_amdgcn_s_sleep(1); \
    if ((++_sp & 255u) == 0u) { if (xb_ld(&(bar)[XB_TMO])) break; if (_sp > XB_SPIN_CAP) { atomicAdd(&(bar)[XB_TMO], 1u); break; } } } } while (0)
struct XcdBarrier { unsigned* bar; unsigned x; volatile LAS unsigned* st; };
__device__ __forceinline__ XcdBarrier xcd_barrier_post(unsigned* bar, volatile LAS unsigned* st) {
    XcdBarrier b; b.bar = bar; b.x = xb_xcc_id(); b.st = st;
    if (threadIdx.x == 0) (void)xb_add(&bar[XB_XCNT(b.x)], 1u);
    return b;
}
__device__ __forceinline__ void xcd_barrier_complete(unsigned* bar, unsigned x, unsigned& nloc, unsigned& nx) {
    const unsigned G = gridDim.x * gridDim.y * gridDim.z;
    unsigned sum, cnt, mine, sp = 0u;
    for (;;) {
        sum = 0u; cnt = 0u; mine = 0u;
#pragma unroll
        for (unsigned j = 0; j < 16; ++j) { const unsigned c = xb_ld(&bar[XB_XCNT(j)]); sum += c; cnt += (c > 0u) ? 1u : 0u; mine = (j == x) ? c : mine; }
        if (sum == G) break;
        __builtin_amdgcn_s_sleep(1);
        if ((++sp & 255u) == 0u) { if (xb_ld(&bar[XB_TMO])) break; if (sp > XB_SPIN_CAP) { atomicAdd(&bar[XB_TMO], 1u); break; } }
    }
    nloc = mine > 0u ? mine : 1u; nx = cnt > 0u ? cnt : 1u;
}
__device__ __forceinline__ void xcd_barrier(const XcdBarrier& b) {
    asm volatile("s_waitcnt vmcnt(0)" ::: "memory");
    __syncthreads();
    if (threadIdx.x == 0) {
        unsigned* bar = b.bar;
        __builtin_amdgcn_s_waitcnt(0);
        unsigned nloc = b.st[0], nx = b.st[1];
        if (nloc == 0u) { xcd_barrier_complete(bar, b.x, nloc, nx); b.st[0] = nloc; b.st[1] = nx; }
        const unsigned old = xb_add(&bar[XB_XSUB(b.x)], 1u);
        const unsigned gen = old / nloc;
        if (old + 1u == (gen + 1u) * nloc) {
            __builtin_amdgcn_fence(__ATOMIC_RELEASE, "agent");
            asm volatile("s_waitcnt vmcnt(0)" ::: "memory");
            const unsigned og = xb_add(&bar[XB_TOP], 1u);
            const unsigned tg = og / nx;
            if (og + 1u == (tg + 1u) * nx) xb_add(&bar[XB_TOPGEN], 1u);
            else XB_SPIN(xb_ld(&bar[XB_TOPGEN]) == tg, bar);
            __builtin_amdgcn_fence(__ATOMIC_ACQUIRE, "agent");
            xb_add(&bar[XB_XGEN(b.x)], 1u);
            asm volatile("s_waitcnt vmcnt(0)" ::: "memory");
        } else {
            XB_SPIN(xb_ld(&bar[XB_XGEN(b.x)]) == gen, bar);
            __builtin_amdgcn_fence(__ATOMIC_ACQUIRE, "agent");
            asm volatile("s_waitcnt vmcnt(0)" ::: "memory");
        }
    }
    __syncthreads();
}

__global__ void __launch_bounds__(NTHR, 2) mega_fwd(Params p_arg) {
    extern __shared__ __attribute__((aligned(16))) unsigned char lds[];
    LAS unsigned char* ldsl = (LAS unsigned char*)lds;
    const int G = gridDim.x;
    const __attribute__((address_space(4))) Params* kp = (const __attribute__((address_space(4))) Params*)__builtin_amdgcn_kernarg_segment_ptr();
    const int ph_lo = kp->ph_lo, ph_hi = kp->ph_hi;
    volatile LAS unsigned* xst = (volatile LAS unsigned*)(ldsl + 131072 + 64);
    if (threadIdx.x == 0) { xst[0] = 0u; xst[1] = 0u; }
    __syncthreads();
    XcdBarrier xbar; xbar.bar = (unsigned*)(kp->ws + WS_BAR); xbar.x = 0; xbar.st = xst;
    if (ph_hi - ph_lo > 1) xbar = xcd_barrier_post((unsigned*)(kp->ws + WS_BAR), xst);
    for (int ph = ph_lo; ph < ph_hi; ++ph) {
        asm volatile("" : "+s"(kp));
        KPR p = *kp;
        unsigned char* ws = p.ws;
        const PhaseDesc pd = PHASES[ph];
        const int layer = pd.layer;
        switch (pd.kind) {
        case K_PREP: if (EN(K_PREP)) phase_prep(p, ldsl, G); break;
        case K_NORM: if (EN(K_NORM)) phase_norm(p, layer, pd.aux, G); break;
        case K_FINAL: if (EN(K_FINAL)) phase_final(p, G); break;
        case K_QKROPE: if (EN(K_QKROPE)) phase_qkrope(p, G); break;
        case K_ATTN: if (EN(K_ATTN)) phase_attn(p, (char*)lds, G); break;
        case K_SGU: if (EN(K_SGU)) phase_sgu(p, (char*)lds, G); break;
        case K_CHANDFT: if (EN(K_CHANDFT)) {
            for (int part = 0; part < 2; ++part) {
                const int lsh = part ? 3 : 4, S_ = part ? SS : SP;
                pg8::Gemm g{(const bf16_t*)(ws + WS_DFTC), (const bf16_t*)(ws + WS_H) + (part ? (size_t)TP * D : 0), 256, D << lsh, 256, 1, 1, 0, 0,
                            lsh, (1 << lsh) - 1, (size_t)S_ * D * 2, (size_t)D * 2, (size_t)256 * 2};
                pg8::StaticOrder S; S.init(8, 16 << lsh, G, blockIdx.x);
                pg8::EpiChanDft E{(bf16_t*)(ws + WS_ZT) + (part ? (size_t)TP * 2048 : 0)};
                pg8::gemm_phase<pg8::EpiChanDft, pg8::StaticOrder, true, true>(ldsl, g, S, E);
            }
        } break;
        case K_SEQDFT: if (EN(K_SEQDFT)) {
            for (int part = 0; part < 2; ++part) {
                const int L = part ? 8 : 16;
                pg8::Gemm g{(const bf16_t*)(ws + (part ? WS_M1S : WS_M1P)), (const bf16_t*)(ws + WS_ZT) + (part ? (size_t)TP * 2048 : 0), 512, 512, 512, 1, 1, L - 1, (size_t)512 * 512 * 2,
                            0, 0, (size_t)256 * 512 * 2, 0, (size_t)1024 * 512 * 2};
                pg8::StaticOrder S; S.init(16 * L * 2, 4, G, blockIdx.x);
                pg8::EpiBf16<0> E{(bf16_t*)(ws + WS_Y) + (part ? (size_t)TP * 2048 : 0), D, 1.0f};
                pg8::gemm_phase<pg8::EpiBf16<0>, pg8::StaticOrder, true, true>(ldsl, g, S, E);
            }
        } break;
        case K_FFT2: if (EN(K_FFT2)) phase_fft2(p, G); break;
        case K_QKV: if (EN(K_QKV)) {
            pg8::Gemm g = pg8::plain_gemm((const bf16_t*)(ws + WS_H), (const bf16_t*)(ws + WS_WQKV), D, D, D);
            pg8::StaticOrder S; S.init(T / 256, NQKV / 256, G, blockIdx.x);
            pg8::EpiBf16<0> E{(bf16_t*)(ws + WS_BIG), NQKV, 1.0f};
            pg8::gemm_phase<pg8::EpiBf16<0>, pg8::StaticOrder, true, true>(ldsl, g, S, E);
        } break;
        case K_WIN: if (EN(K_WIN)) {
            pg8::Gemm g = pg8::plain_gemm((const bf16_t*)(ws + WS_H), (const bf16_t*)(ws + WS_WIN), D, D, D);
            pg8::StaticOrder S; S.init(T / 256, 2048 / 256, G, blockIdx.x);
            pg8::EpiBf16<1> E{(bf16_t*)(ws + WS_BIG), 2048, 1.0f};
            pg8::gemm_phase<pg8::EpiBf16<1>, pg8::StaticOrder, true, true>(ldsl, g, S, E);
        } break;
        case K_GU: if (EN(K_GU)) {
            pg8::Gemm g = pg8::plain_gemm((const bf16_t*)(ws + WS_H), (const bf16_t*)(ws + WS_WGU) + (size_t)layer * D * 2 * FF, D, D, D);
            pg8::StaticOrder S; S.init(T / 256, 2 * FF / 256, G, blockIdx.x);
            pg8::EpiSwiGlu E{(bf16_t*)(ws + WS_BIG)};
            pg8::gemm_phase<pg8::EpiSwiGlu, pg8::StaticOrder, true, true>(ldsl, g, S, E);
        } break;
        case K_RESID: if (EN(K_RESID)) {
            const int aux = pd.aux; const bool first = (layer == 0 && aux != 4);
            const bf16_t* A = (const bf16_t*)(ws + (aux == 4 ? WS_BIG : aux < 2 ? WS_ZT : WS_H));
            const bf16_t* W = aux == 0 ? (const bf16_t*)(ws + WS_FNETW) : aux == 1 ? (const bf16_t*)(ws + WS_FNETW) + (size_t)D * D : aux == 2 ? (const bf16_t*)(ws + WS_WAO)
                            : aux == 3 ? (const bf16_t*)(ws + WS_WSO) : (const bf16_t*)(ws + WS_WDN) + (size_t)layer * FF * D;
            const int K = aux == 4 ? FF : D;
            pg8::Gemm g = pg8::plain_gemm(A, W, K, K, K);
            pg8::StaticOrder S; S.init(T / 256, D / 256, G, blockIdx.x);
            pg8::EpiResid E{first ? p.x_prompt : p.out, first ? p.x_sample - (size_t)TP * D : p.out, p.out,
                            (const float*)(ws + WS_MOD) + (size_t)layer * 32 * NMOD + (aux == 4 ? 5 : 2) * D};
            pg8::gemm_phase<pg8::EpiResid, pg8::StaticOrder, true, true>(ldsl, g, S, E);
        } break;
        }
        if (ph + 1 < ph_hi) {
            if (ph == ph_lo) { __threadfence(); cg::this_grid().sync(); }
            else xcd_barrier(xbar);
        }
    }
}

extern "C" void kernel_launch(void* const* d_in, const int* in_sizes, int n_in, void* d_out, int out_size, void* d_ws, size_t ws_size, hipStream_t stream) {
    static int grid = 0;
    if (grid == 0) {
        if (n_in != 22 || in_sizes[0] != TP * D || in_sizes[1] != TS * D || out_size != T * D || ws_size < WS_END) {
            fprintf(stderr, "kernel_launch: shape mismatch n_in %d in0 %d in1 %d out %d ws %zu (need %zu)\n", n_in, n_in > 0 ? in_sizes[0] : -1, n_in > 1 ? in_sizes[1] : -1, out_size, ws_size, (size_t)WS_END);
            grid = -1; return; }
        int dev = 0, cus = 0, per_cu = 0;
        if (hipGetDevice(&dev) != hipSuccess || hipDeviceGetAttribute(&cus, hipDeviceAttributeMultiprocessorCount, dev) != hipSuccess) { grid = -1; return; }
        if (hipFuncSetAttribute((const void*)mega_fwd, hipFuncAttributeMaxDynamicSharedMemorySize, LDS_BYTES) != hipSuccess) { fprintf(stderr, "kernel_launch: hipFuncSetAttribute failed\n"); grid = -1; return; }
        if (hipOccupancyMaxActiveBlocksPerMultiprocessor(&per_cu, (const void*)mega_fwd, NTHR, LDS_BYTES) != hipSuccess || per_cu < 1) { fprintf(stderr, "kernel_launch: occupancy query gave %d\n", per_cu); per_cu = 1; }
        (void)hipGetLastError();
        grid = cus * per_cu;
        fprintf(stderr, "kernel_launch: grid %d (cus %d x %d)\n", grid, cus, per_cu);
    }
    if (grid < 0) return;
    Params p{};
    p.x_prompt = (const float*)d_in[0]; p.x_sample = (const float*)d_in[1]; p.c_prompt = (const float*)d_in[2]; p.c_sample = (const float*)d_in[3];
    p.norm1_g = (const float*)d_in[4]; p.norm2_g = (const float*)d_in[5]; p.w_ada = (const float*)d_in[6]; p.b_ada = (const float*)d_in[7];
    p.fnet_w_o = (const float*)d_in[8]; p.attn_w_qkv = (const float*)d_in[9]; p.attn_q_g = (const float*)d_in[10]; p.attn_k_g = (const float*)d_in[11]; p.attn_w_o = (const float*)d_in[12];
    p.sgu_w_in = (const float*)d_in[13]; p.sgu_ln_g = (const float*)d_in[14]; p.sgu_ln_b = (const float*)d_in[15]; p.sgu_w_s = (const float*)d_in[16]; p.sgu_b_s = (const float*)d_in[17]; p.sgu_w_o = (const float*)d_in[18];
    p.ffn_w_gu = (const float*)d_in[19]; p.ffn_w_down = (const float*)d_in[20]; p.final_g = (const float*)d_in[21];
    p.out = (float*)d_out; p.ws = (unsigned char*)d_ws;
#if MK_SINGLE
    if (hipMemsetAsync((char*)d_ws + WS_BAR, 0, BAR_BYTES, stream) != hipSuccess) { fprintf(stderr, "kernel_launch: memset failed\n"); return; }
    p.ph_lo = 0; p.ph_hi = NPH;
    void* args[] = {&p};
    hipError_t e = hipLaunchCooperativeKernel((const void*)mega_fwd, dim3(grid), dim3(NTHR), args, LDS_BYTES, stream);
    if (e != hipSuccess) fprintf(stderr, "kernel_launch: cooperative launch failed: %s (grid %d)\n", hipGetErrorString(e), grid);
#else
    for (int ph = 0; ph < NPH; ++ph) {
        p.ph_lo = ph; p.ph_hi = ph + 1;
        hipLaunchKernelGGL(mega_fwd, dim3(grid), dim3(NTHR), LDS_BYTES, stream, p);
    }
    const hipError_t le = hipPeekAtLastError();
    if (le != hipSuccess) fprintf(stderr, "kernel_launch: launch failed: %s\n", hipGetErrorName(le));
#endif
}
```

```cpp
#include <hip/hip_runtime.h>
#include <hip/hip_cooperative_groups.h>
#include <cstdio>
#include <cstdint>
namespace cg = cooperative_groups;

#ifndef MK_EN
#define MK_EN 0x1FFF
#endif
#define EN(k) (((MK_EN) >> (k)) & 1)
#ifndef MK_DUP
#define MK_DUP 0
#endif
#ifndef MK_SINGLE
#define MK_SINGLE 1
#endif

#define LAS __attribute__((address_space(3)))
typedef unsigned short bf16_t;
typedef short bf16x8 __attribute__((ext_vector_type(8)));
typedef short s16x4 __attribute__((ext_vector_type(4)));
typedef _Float16 h16x2 __attribute__((ext_vector_type(2)));
typedef _Float16 h16x4 __attribute__((ext_vector_type(4)));
typedef _Float16 h16x8 __attribute__((ext_vector_type(8)));
typedef float f32x2 __attribute__((ext_vector_type(2)));
typedef float f32x4 __attribute__((ext_vector_type(4)));
typedef float f32x16 __attribute__((ext_vector_type(16)));
typedef unsigned u32x2 __attribute__((ext_vector_type(2)));
typedef unsigned u32x4 __attribute__((ext_vector_type(4)));

constexpr int D = 1024, TP = 65536, TS = 32768, T = TP + TS, SP = 4096, SS = 2048, FF = 2816, NQKV = 1536, NMOD = 6144;
constexpr float EPS = 1e-6f;
constexpr int NWAVES = 8, NTHR = 512;
constexpr int LDS_BYTES = 147456;

__device__ __forceinline__ int seq_of(int row) { return row < TP ? (row >> 12) : 16 + ((row - TP) >> 11); }
__device__ __forceinline__ int seq_start(int s) { return s < 16 ? (s << 12) : TP + ((s - 16) << 11); }
__device__ __forceinline__ int seq_len(int s) { return s < 16 ? SP : SS; }
__device__ __forceinline__ size_t zt_base(int s) { return s < 16 ? (size_t)s * (1024u * 8192u) : (size_t)16 * (1024u * 8192u) + (size_t)(s - 16) * (1024u * 4096u); }

constexpr size_t MiB = 1u << 20;
constexpr size_t WS_MOD = 0;
constexpr size_t WS_DFTC = 3 * MiB;
constexpr size_t WS_WSB = WS_DFTC + 256 * 1024;
constexpr size_t WS_BAR = WS_WSB + 256 * 1024, BAR_BYTES = 16384;
constexpr size_t WS_FNETW = 4 * MiB;
constexpr size_t WS_WQKV = 8 * MiB;
constexpr size_t WS_WAO = 11 * MiB;
constexpr size_t WS_WIN = 13 * MiB;
constexpr size_t WS_WSO = 17 * MiB;
constexpr size_t WS_WGU = 19 * MiB;
constexpr size_t WS_WDN = 63 * MiB;
constexpr size_t WS_M1P = 85 * MiB;
constexpr size_t WS_M1S = 93 * MiB;
constexpr size_t WS_X16 = 165 * MiB;
constexpr size_t WS_BIG = 357 * MiB;
constexpr size_t WS_ZT = 549 * MiB;
constexpr size_t WS_END = 933 * MiB;

__device__ __forceinline__ unsigned f2bf(float f) { unsigned u = __builtin_bit_cast(unsigned, f); return (u + 0x7fffu + ((u >> 16) & 1u)) >> 16; }
__device__ __forceinline__ unsigned pk2(float lo, float hi) { return f2bf(lo) | (f2bf(hi) << 16); }
__device__ __forceinline__ float bf2f(unsigned short b) { return __builtin_bit_cast(float, ((unsigned)b) << 16); }
__device__ __forceinline__ unsigned cvt_pk_bf16(float lo, float hi) { unsigned r; asm volatile("v_cvt_pk_bf16_f32 %0, %1, %2" : "=v"(r) : "v"(lo), "v"(hi)); return r; }
__device__ __forceinline__ unsigned pkh2(float lo, float hi) { const h16x2 v = {(_Float16)lo, (_Float16)hi}; return __builtin_bit_cast(unsigned, v); }
__device__ __forceinline__ float wave_sum(float v) {
#pragma unroll
    for (int o = 1; o < 64; o <<= 1) v += __shfl_xor(v, o);
    return v;
}
__device__ __forceinline__ int tid_opaque() { int t = threadIdx.x; asm volatile("" : "+v"(t)); return t; }
#define LDS_WAIT() asm volatile("s_waitcnt lgkmcnt(0)" ::: "memory")

namespace pg8 {
constexpr int BM = 256, BK = 64, HALF = 128, HTB = HALF * BK * 2, STAGE_BYTES = 8 * HTB, NXCD = 8, WGM = 8;
__host__ __device__ __forceinline__ int lds_byte(int r, int c) { const int st = (r >> 4) * 2 + (c >> 5), rr = r & 15, cc = c & 31, ob = rr * 64 + cc * 2; return st * 1024 + (ob ^ (((ob >> 9) & 1) << 5)); }
__host__ __device__ __forceinline__ void stage_rc(int b, int& R, int& C) { const int st = b / 1024, sb = b % 1024, swz = sb ^ (((sb >> 9) & 1) << 5); R = (st >> 1) * 16 + swz / 64; C = (st & 1) * 32 + (swz % 64) / 2; }
__host__ __device__ __forceinline__ int perm32(int rho) { const int n = rho >> 4, i = rho & 15; return 8 * (i >> 2) + 4 * n + (i & 3); }

struct Unit { int pm, pn; };
struct Gemm { const bf16_t* A; const bf16_t* Bt; int lda, ldb, K; int am0, ash, am1; size_t sA; int bsh, bm0; size_t sB1, sB2, sB; };
__device__ __forceinline__ Gemm plain_gemm(const bf16_t* A, const bf16_t* Bt, int lda, int ldb, int K) { return Gemm{A, Bt, lda, ldb, K, 0x3fffffff, 30, 0, 0, 0, 0, (size_t)256 * ldb * 2, 0, 0}; }

struct StaticOrder {
    int nM, nN, nwg, G, c;
    __device__ void init(int nM_, int nN_, int G_, int c_) { nM = nM_; nN = nN_; nwg = nM * nN; G = G_; c = c_; }
    __device__ bool next(int i, Unit& u) const {
        const long L = (long)i * G + c; if (L >= nwg) return false;
        int wgid = (int)L; { const int q = nwg / NXCD, r = nwg % NXCD, xcd = wgid % NXCD, off = wgid / NXCD; wgid = (xcd < r ? xcd * (q + 1) : r * (q + 1) + (xcd - r) * q) + off; }
        const int nig = WGM * nN, gid = wgid / nig, fm = gid * WGM, gsz = (nM - fm) < WGM ? (nM - fm) : WGM;
        u.pm = fm + ((wgid % nig) % gsz); u.pn = (wgid % nig) / gsz; return true;
    }
};

__device__ __forceinline__ f32x2 gelu_pk(f32x2 v) {
    const f32x2 av = __builtin_elementwise_abs(v), d = av * 0.2316418882f + 1.0f;
    f32x2 t; t.x = __builtin_amdgcn_rcpf(d.x); t.y = __builtin_amdgcn_rcpf(d.y);
    f32x2 q = t * 0.5307027145f + (-0.7265760135f); q = q * t + 0.7107068705f; q = q * t + (-0.142248368f); q = q * t + 0.127414796f; q = q * t;
    const f32x2 s = (v * v) * (-0.72134752044f);
    f32x2 e; e.x = __builtin_amdgcn_exp2f(s.x); e.y = __builtin_amdgcn_exp2f(s.y);
    const f32x2 m = v * (q * e), r = v - m;
    f32x2 o; o.x = v.x < 0.f ? m.x : r.x; o.y = v.y < 0.f ? m.y : r.y; return o;
}

template <int ACT> struct EpiBf16 {
    static constexpr bool PERM = true;
    bf16_t* O; int ldc; float scale;
    __device__ __forceinline__ void operator()(const f32x4 (&acc)[2][2][4][2], const Unit& u, int wr, int wc, int fr, int fq) const {
        const unsigned row0 = u.pm * BM + wr * 64 + fr, col0 = u.pn * BM + wc * 32 + 8 * fq;
        char* Ob = (char*)O;
#pragma unroll
        for (int ai = 0; ai < 2; ++ai)
#pragma unroll
            for (int m = 0; m < 4; ++m) { const unsigned ob = ((row0 + ai * HALF + m * 16) * (unsigned)ldc + col0) * 2u;
#pragma unroll
                for (int bj = 0; bj < 2; ++bj) { f32x4 v0 = acc[ai][bj][m][0], v1 = acc[ai][bj][m][1];
                    if (ACT == 1) { f32x2 a = gelu_pk((f32x2){v0[0], v0[1]}), b = gelu_pk((f32x2){v0[2], v0[3]}), c = gelu_pk((f32x2){v1[0], v1[1]}), d = gelu_pk((f32x2){v1[2], v1[3]});
                        v0 = (f32x4){a.x, a.y, b.x, b.y}; v1 = (f32x4){c.x, c.y, d.x, d.y}; }
                    v0 = v0 * scale; v1 = v1 * scale;
                    u32x4 w; w.x = cvt_pk_bf16(v0[0], v0[1]); w.y = cvt_pk_bf16(v0[2], v0[3]); w.z = cvt_pk_bf16(v1[0], v1[1]); w.w = cvt_pk_bf16(v1[2], v1[3]);
                    *(u32x4*)(Ob + (size_t)(ob + bj * HALF * 2)) = w; } }
    }
};
struct EpiChanDft {
    static constexpr bool PERM = true;
    bf16_t* Zt;
    __device__ __forceinline__ void operator()(const f32x4 (&acc)[2][2][4][2], const Unit& u, int wr, int wc, int fr, int fq) const {
        const int g = u.pm >> 1, cs = u.pm & 1;
        char* base = (char*)Zt + ((size_t)u.pn * 1024 * 512 + (size_t)cs * 256) * 2;
        const unsigned lo = ((unsigned)(g * 256 + wr * 64 + fr) * 512u + (unsigned)(wc * 32 + 8 * fq)) * 2u;
#pragma unroll
        for (int ai = 0; ai < 2; ++ai)
#pragma unroll
            for (int m = 0; m < 4; ++m) { const unsigned ob = lo + (unsigned)(ai * HALF + m * 16) * 1024u;
#pragma unroll
                for (int bj = 0; bj < 2; ++bj) { const f32x4 v0 = acc[ai][bj][m][0] * 0.0625f, v1 = acc[ai][bj][m][1] * 0.0625f;
                    u32x4 w; w.x = cvt_pk_bf16(v0[0], v0[1]); w.y = cvt_pk_bf16(v0[2], v0[3]); w.z = cvt_pk_bf16(v1[0], v1[1]); w.w = cvt_pk_bf16(v1[2], v1[3]);
                    *(u32x4*)(base + (size_t)(ob + bj * HALF * 2)) = w; }
                asm volatile("" ::: "memory"); }
    }
};
struct EpiSwiGlu {
    static constexpr bool PERM = true;
    bf16_t* Hd;
    __device__ __forceinline__ void operator()(const f32x4 (&acc)[2][2][4][2], const Unit& u, int wr, int wc, int fr, int fq) const {
        const unsigned row0 = u.pm * BM + wr * 64 + fr, col0 = u.pn * HALF + wc * 32 + 8 * fq;
        char* Hb = (char*)Hd;
#pragma unroll
        for (int ai = 0; ai < 2; ++ai)
#pragma unroll
            for (int m = 0; m < 4; ++m) { const unsigned ob = ((row0 + ai * HALF + m * 16) * (unsigned)FF + col0) * 2u;
                float o[8];
#pragma unroll
                for (int n = 0; n < 2; ++n)
#pragma unroll
                    for (int e = 0; e < 4; ++e) { const float gv = acc[ai][0][m][n][e], uv = acc[ai][1][m][n][e];
                        const float sg = gv * __builtin_amdgcn_rcpf(1.0f + __builtin_amdgcn_exp2f(-1.4426950408889634f * gv)); o[n * 4 + e] = sg * uv; }
                u32x4 w; w.x = cvt_pk_bf16(o[0], o[1]); w.y = cvt_pk_bf16(o[2], o[3]); w.z = cvt_pk_bf16(o[4], o[5]); w.w = cvt_pk_bf16(o[6], o[7]);
                *(u32x4*)(Hb + (size_t)ob) = w; }
    }
};
struct EpiResid {
    static constexpr bool PERM = true;
    const float* srcP; const float* srcS;
    _Float16* x16; int first;
    const float* gate;
    __device__ __forceinline__ void operator()(const f32x4 (&acc)[2][2][4][2], const Unit& u, int wr, int wc, int fr, int fq) const {
        const unsigned row0 = u.pm * BM + wr * 64 + fr, col0 = u.pn * BM + wc * 32 + 8 * fq;
        const int sq = seq_of(u.pm * BM); const float* gp = gate + (size_t)sq * NMOD; const char* sb = (const char*)((u.pm * BM < TP) ? srcP : srcS); char* xb = (char*)x16;
        f32x4 gv[2][2];
#pragma unroll
        for (int bj = 0; bj < 2; ++bj)
#pragma unroll
            for (int n = 0; n < 2; ++n) gv[bj][n] = *(const f32x4*)(gp + col0 + bj * HALF + n * 4);
#pragma unroll
        for (int ai = 0; ai < 2; ++ai)
#pragma unroll
            for (int m = 0; m < 4; ++m) { const unsigned eo = (row0 + ai * HALF + m * 16) * (unsigned)D + col0;
#pragma unroll
                for (int bj = 0; bj < 2; ++bj) { const unsigned e2 = eo + bj * HALF; f32x4 x0, x1;
                    if (first) { x0 = *(const f32x4*)(sb + (size_t)(e2 * 4u)); x1 = *(const f32x4*)(sb + (size_t)(e2 * 4u + 16u)); }
                    else { const h16x8 hv = *(const h16x8*)(xb + (size_t)(e2 * 2u)); x0 = (f32x4){(float)hv[0], (float)hv[1], (float)hv[2], (float)hv[3]}; x1 = (f32x4){(float)hv[4], (float)hv[5], (float)hv[6], (float)hv[7]}; }
                    x0 = x0 + gv[bj][0] * acc[ai][bj][m][0]; x1 = x1 + gv[bj][1] * acc[ai][bj][m][1];
                    u32x4 w; w.x = pkh2(x0[0], x0[1]); w.y = pkh2(x0[2], x0[3]); w.z = pkh2(x1[0], x1[1]); w.w = pkh2(x1[2], x1[3]);
                    *(u32x4*)(xb + (size_t)(e2 * 2u)) = w; }
                asm volatile("" ::: "memory"); }
    }
};

template <class Epi, class Sched, bool ALIGN_EPI, bool SP2>
__device__ __forceinline__ void gemm_phase(LAS unsigned char* lds, const Gemm g, const Sched& S, const Epi& E) {
    const int tid = tid_opaque(), wid = __builtin_amdgcn_readfirstlane(tid >> 6), lane = tid & 63, wr = wid >> 2, wc = wid & 3, fr = lane & 15, fq = lane >> 4;
    int K = g.K; asm volatile("" : "+s"(K));
    const int nt = K / BK;
    unsigned voffA[2], voffB[2];
#pragma unroll
    for (int i = 0; i < 2; ++i) { int R, C; stage_rc(tid * 16 + i * 8192, R, C); const int Rb = Epi::PERM ? ((R & ~31) + perm32(R & 31)) : R;
        voffA[i] = (unsigned)(R * g.lda + C) * 2u; voffB[i] = (unsigned)(Rb * g.ldb + C) * 2u; }
    const size_t kstep = (size_t)(BK * 2);
    const size_t hA = (size_t)HALF * g.lda * 2, hB = (size_t)HALF * g.ldb * 2, tA = 2 * hA;
    const unsigned ldsw = (unsigned)wid * 1024u;
    const int aoff = lds_byte(wr * 64 + fr, fq * 8), boff = lds_byte(wc * 32 + fr, fq * 8);
#define PG8_SA(b, h) (((b) * 2 + (h)) * HTB)
#define PG8_SB(b, h) ((4 + (b) * 2 + (h)) * HTB)
#define PG8_STAGE(bufoff, gbase, voff) do { _Pragma("unroll") for (int _i = 0; _i < 2; ++_i) \
        __builtin_amdgcn_global_load_lds((const unsigned*)((const char*)(gbase) + (voff)[_i]), (LAS unsigned*)(lds + (bufoff) + ldsw + _i * 8192), 16, 0, 0); } while (0)
#define PG8_LDA(dst, b, h) do { _Pragma("unroll") for (int m = 0; m < 4; ++m) _Pragma("unroll") for (int k = 0; k < 2; ++k) dst[m][k] = *(const LAS bf16x8*)(lds + PG8_SA(b, h) + aoff + m * 2048 + k * 1024); } while (0)
#define PG8_LDB(dst, b, h) do { _Pragma("unroll") for (int n = 0; n < 2; ++n) _Pragma("unroll") for (int k = 0; k < 2; ++k) dst[n][k] = *(const LAS bf16x8*)(lds + PG8_SB(b, h) + boff + n * 2048 + k * 1024); } while (0)
#define PG8_MMA(ai, bj, At, Bt) do { __builtin_amdgcn_s_setprio(1); _Pragma("unroll") for (int m = 0; m < 4; ++m) _Pragma("unroll") for (int n = 0; n < 2; ++n) _Pragma("unroll") for (int k = 0; k < 2; ++k) \
        acc[ai][bj][m][n] = __builtin_amdgcn_mfma_f32_16x16x32_bf16(Bt[n][k], At[m][k], acc[ai][bj][m][n], 0, 0, 0); __builtin_amdgcn_s_setprio(0); } while (0)
#define PG8_WAIT_V(n) asm volatile("s_waitcnt vmcnt(" #n ")" ::: "memory")
#define PG8_WAIT_L(n) asm volatile("s_waitcnt lgkmcnt(" #n ")" ::: "memory")
#define PG8_BAR __builtin_amdgcn_s_barrier()
#define PG8_SCHED __builtin_amdgcn_sched_barrier(0)
#define PG8_ABASE(u) ((const char*)g.A + (size_t)((u).pm & g.am0) * tA + (size_t)(((u).pm >> g.ash) & g.am1) * g.sA)
#define PG8_BBASE(u) ((const char*)g.Bt + (size_t)((u).pn >> g.bsh) * g.sB1 + (size_t)((u).pn & g.bm0) * g.sB2 + (size_t)((u).pm >> g.ash) * g.sB)
    Unit cur, nxt; int ui = 0;
    if (!S.next(0, cur)) return;
    f32x4 acc[2][2][4][2];
#pragma unroll
    for (int a = 0; a < 2; ++a)
#pragma unroll
        for (int b = 0; b < 2; ++b)
#pragma unroll
            for (int m = 0; m < 4; ++m)
#pragma unroll
                for (int n = 0; n < 2; ++n) acc[a][b][m][n] = (f32x4){0.f, 0.f, 0.f, 0.f};
    bf16x8 At[4][2], B0[2][2], B1[2][2];
    const char* cA = PG8_ABASE(cur); const char* cB = PG8_BBASE(cur);
    if constexpr (SP2) {
        PG8_STAGE(PG8_SB(0, 0), cB, voffB); PG8_STAGE(PG8_SB(0, 1), cB + hB, voffB); PG8_STAGE(PG8_SA(0, 0), cA, voffA); PG8_STAGE(PG8_SA(0, 1), cA + hA, voffA);
        if (wr == 1) PG8_BAR;
        PG8_WAIT_V(2); PG8_BAR;
        PG8_STAGE(PG8_SB(1, 0), cB + kstep, voffB); PG8_STAGE(PG8_SA(1, 0), cA + kstep, voffA); PG8_STAGE(PG8_SB(1, 1), cB + hB + kstep, voffB);
        PG8_WAIT_V(6); PG8_BAR;
    } else {
        PG8_STAGE(PG8_SB(0, 0), cB, voffB); PG8_STAGE(PG8_SA(0, 0), cA, voffA); PG8_STAGE(PG8_SB(0, 1), cB + hB, voffB); PG8_STAGE(PG8_SA(0, 1), cA + hA, voffA);
        if (wr == 1) PG8_BAR;
        PG8_WAIT_V(4); PG8_BAR;
        PG8_STAGE(PG8_SB(1, 0), cB + kstep, voffB); PG8_STAGE(PG8_SA(1, 0), cA + kstep, voffA); PG8_STAGE(PG8_SB(1, 1), cB + hB + kstep, voffB);
        PG8_WAIT_V(6); PG8_BAR;
    }
    for (;;) {
        const bool has_next = S.next(ui + 1, nxt);
        const char* nA = has_next ? PG8_ABASE(nxt) : cA; const char* nB = has_next ? PG8_BBASE(nxt) : cB;
        for (int t = 0; t < nt; t += 2) {
            const bool last = (t == nt - 2);
            const char* a1 = cA + (size_t)(t + 1) * kstep;
            const char* a2 = last ? nA : cA + (size_t)(t + 2) * kstep; const char* b2 = last ? nB : cB + (size_t)(t + 2) * kstep;
            const char* a3 = a2 + kstep; const char* b3 = b2 + kstep;
            if constexpr (SP2) {
            PG8_LDB(B0, 0, 0); PG8_LDB(B1, 0, 1); PG8_SCHED; PG8_LDA(At, 0, 0); PG8_STAGE(PG8_SA(1, 1), a1 + hA, voffA);
            PG8_WAIT_V(8); PG8_WAIT_L(0); PG8_BAR; PG8_MMA(0, 0, At, B0); PG8_MMA(0, 1, At, B1); PG8_BAR; PG8_SCHED;
            PG8_LDA(At, 0, 1); PG8_STAGE(PG8_SB(0, 0), b2, voffB); PG8_STAGE(PG8_SB(0, 1), b2 + hB, voffB); PG8_STAGE(PG8_SA(0, 0), a2, voffA);
            PG8_WAIT_V(8); PG8_WAIT_L(0); PG8_BAR; PG8_MMA(1, 0, At, B0); PG8_MMA(1, 1, At, B1); PG8_BAR; PG8_SCHED;
            PG8_LDB(B0, 1, 0); PG8_LDB(B1, 1, 1); PG8_SCHED; PG8_LDA(At, 1, 0); PG8_STAGE(PG8_SA(0, 1), a2 + hA, voffA);
            PG8_WAIT_V(8); PG8_WAIT_L(0); PG8_BAR; PG8_MMA(0, 0, At, B0); PG8_MMA(0, 1, At, B1); PG8_BAR; PG8_SCHED;
            PG8_LDA(At, 1, 1); PG8_STAGE(PG8_SB(1, 0), b3, voffB); PG8_STAGE(PG8_SB(1, 1), b3 + hB, voffB); PG8_STAGE(PG8_SA(1, 0), a3, voffA);
            PG8_WAIT_V(8); PG8_WAIT_L(0); PG8_BAR; PG8_MMA(1, 0, At, B0); PG8_MMA(1, 1, At, B1); PG8_BAR; PG8_SCHED;
            } else {
            PG8_LDB(B0, 0, 0); PG8_SCHED; PG8_LDA(At, 0, 0); PG8_STAGE(PG8_SA(1, 1), a1 + hA, voffA);
            PG8_WAIT_L(8); PG8_BAR; PG8_WAIT_L(0); PG8_MMA(0, 0, At, B0); PG8_BAR; PG8_SCHED;
            PG8_LDB(B1, 0, 1); PG8_STAGE(PG8_SB(0, 0), b2, voffB);
            PG8_BAR; PG8_WAIT_L(0); PG8_MMA(0, 1, At, B1); PG8_BAR;
            PG8_LDA(At, 0, 1); PG8_STAGE(PG8_SA(0, 0), a2, voffA);
            PG8_BAR; PG8_WAIT_L(0); PG8_MMA(1, 0, At, B0); PG8_BAR; PG8_SCHED;
            PG8_STAGE(PG8_SB(0, 1), b2 + hB, voffB);
            PG8_WAIT_V(6); PG8_BAR; PG8_MMA(1, 1, At, B1); PG8_BAR;
            PG8_LDB(B0, 1, 0); PG8_SCHED; PG8_LDA(At, 1, 0); PG8_STAGE(PG8_SA(0, 1), a2 + hA, voffA);
            PG8_WAIT_L(8); PG8_BAR; PG8_WAIT_L(0); PG8_MMA(0, 0, At, B0); PG8_BAR; PG8_SCHED;
            PG8_LDB(B1, 1, 1); PG8_STAGE(PG8_SB(1, 0), b3, voffB);
            PG8_BAR; PG8_WAIT_L(0); PG8_MMA(0, 1, At, B1); PG8_BAR;
            PG8_LDA(At, 1, 1); PG8_STAGE(PG8_SA(1, 0), a3, voffA);
            PG8_BAR; PG8_WAIT_L(0); PG8_MMA(1, 0, At, B0); PG8_BAR; PG8_SCHED;
            PG8_STAGE(PG8_SB(1, 1), b3 + hB, voffB);
            PG8_WAIT_V(6); PG8_BAR; PG8_MMA(1, 1, At, B1); PG8_BAR;
            }
        }
        if constexpr (ALIGN_EPI) { if (wr == 0) PG8_BAR; }
        E(acc, cur, wr, wc, fr, fq);
        if (!has_next) break;
#pragma unroll
        for (int a = 0; a < 2; ++a)
#pragma unroll
            for (int b = 0; b < 2; ++b)
#pragma unroll
                for (int m = 0; m < 4; ++m)
#pragma unroll
                    for (int n = 0; n < 2; ++n) acc[a][b][m][n] = (f32x4){0.f, 0.f, 0.f, 0.f};
        cur = nxt; cA = nA; cB = nB; ++ui;
        if constexpr (ALIGN_EPI) { if (wr == 1) PG8_BAR; }
    }
    PG8_WAIT_V(0);
    if constexpr (!ALIGN_EPI) { if (wr == 0) PG8_BAR; }
    PG8_BAR;
#undef PG8_SA
#undef PG8_SB
#undef PG8_STAGE
#undef PG8_LDA
#undef PG8_LDB
#undef PG8_MMA
#undef PG8_WAIT_V
#undef PG8_WAIT_L
#undef PG8_BAR
#undef PG8_SCHED
#undef PG8_ABASE
#undef PG8_BBASE
}
}

namespace att {
constexpr int AD = 128, NW = 8, QBLK = 32, KVBLK = 64;
constexpr float SCALE = 0.088388347648318440f;
constexpr float THR = 8.f;
constexpr int LDQ = NQKV, LDK = NQKV, LDO = D;
constexpr size_t SHM_V = KVBLK * AD * 2, SHM_K = KVBLK * AD * 2, SHM_ATTN = 2 * SHM_V + 2 * SHM_K + NW * 64 * 4;
#define KSWZ(row, colB) ((row) * 256 + ((colB) ^ (((row) & 7) << 4)))
#define SBAR() __builtin_amdgcn_sched_barrier(0)
__device__ __forceinline__ int crow(int r, int hi) { return (r & 3) + 8 * (r >> 2) + 4 * hi; }
__device__ __forceinline__ unsigned cvtpk(float lo, float hi) { unsigned r; asm volatile("v_cvt_pk_bf16_f32 %0, %1, %2" : "=v"(r) : "v"(lo), "v"(hi)); return r; }
__device__ __forceinline__ void partialSM(f32x16& p0, f32x16& p1, float& m_reg, float& mn, float& alpha) {
  constexpr float C = SCALE * 1.4426950408889634f;
  float pmax = p0[0]; for (int r = 1; r < 16; ++r) pmax = fmaxf(pmax, p0[r]); for (int r = 0; r < 16; ++r) pmax = fmaxf(pmax, p1[r]);
  { auto rr = __builtin_amdgcn_permlane32_swap(__float_as_uint(pmax), __float_as_uint(pmax), false, false);
    pmax = fmaxf(__uint_as_float(rr[0]), __uint_as_float(rr[1])); }
  if (__builtin_expect(__all(pmax - m_reg <= THR / SCALE), 1)) { mn = m_reg; alpha = 1.f; }
  else { mn = fmaxf(m_reg, pmax); alpha = __builtin_amdgcn_exp2f((m_reg - mn) * C); m_reg = mn; }
  float mnC = -mn * C;
  for (int r = 0; r < 16; ++r) p0[r] = fmaf(p0[r], C, mnC); for (int r = 0; r < 16; ++r) p1[r] = fmaf(p1[r], C, mnC);
  for (int r = 0; r < 16; ++r) p0[r] = __builtin_amdgcn_exp2f(p0[r]);
}
__device__ __forceinline__ void finishSM(f32x16& p0, f32x16& p1, float alpha, float& l_reg, bf16x8& pa0, bf16x8& pa1, bf16x8& pa2, bf16x8& pa3) {
  for (int r = 0; r < 16; ++r) p1[r] = __builtin_amdgcn_exp2f(p1[r]);
  float ps = 0; for (int r = 0; r < 16; ++r) ps += p0[r]; for (int r = 0; r < 16; ++r) ps += p1[r];
  { auto rr = __builtin_amdgcn_permlane32_swap(__float_as_uint(ps), __float_as_uint(ps), false, false);
    ps = __uint_as_float(rr[0]) + __uint_as_float(rr[1]); }
  l_reg = l_reg * alpha + ps;
#define PK4(P, BASE, OUT) do { unsigned a0 = cvtpk(P[BASE + 0], P[BASE + 1]), a1 = cvtpk(P[BASE + 2], P[BASE + 3]);   \
    unsigned b0 = cvtpk(P[BASE + 4], P[BASE + 5]), b1 = cvtpk(P[BASE + 6], P[BASE + 7]);                              \
    auto r0 = __builtin_amdgcn_permlane32_swap(a0, b0, false, false); auto r1 = __builtin_amdgcn_permlane32_swap(a1, b1, false, false); \
    u32x4 w = {r0[0], r1[0], r0[1], r1[1]}; OUT = *reinterpret_cast<bf16x8*>(&w); } while (0)
  PK4(p0, 0, pa0); PK4(p0, 8, pa1); PK4(p1, 0, pa2); PK4(p1, 8, pa3);
#undef PK4
}
__device__ __forceinline__ void qkt(f32x16& p0, f32x16& p1, const bf16_t* Ks, const bf16x8* qr, int r32, int hi) {
  p0 = f32x16{}; p1 = f32x16{};
  for (int d0 = 0; d0 < 8; ++d0) { int cb = (d0 * 16 + hi * 8) * 2;
    bf16x8 b0 = *reinterpret_cast<const bf16x8*>((const char*)Ks + KSWZ(r32, cb));
    bf16x8 b1 = *reinterpret_cast<const bf16x8*>((const char*)Ks + KSWZ(32 + r32, cb));
    p0 = __builtin_amdgcn_mfma_f32_32x32x16_bf16(b0, qr[d0], p0, 0, 0, 0);
    p1 = __builtin_amdgcn_mfma_f32_32x32x16_bf16(b1, qr[d0], p1, 0, 0, 0); }
}
__device__ __forceinline__ int v_st(int k, int c) { const int kk = (k & ~0xC) | ((k & 4) << 1) | ((k & 8) >> 1); return ((kk >> 3) * 4 + (c >> 5)) * 512 + ((kk & 7) * 32 + (c & 31)) * 2; }
__device__ __forceinline__ int v_rd_base(int lane) { return ((lane & 3) << 3) | (((lane >> 2) & 3) << 6) | (((lane >> 4) & 1) << 5) | (((lane >> 5) & 1) << 8); }
constexpr int v_rd_off(int d0, int ks, int half) { return d0 * 512 + ks * 4096 + half * 2048; }
template <int OFF> __device__ __forceinline__ s16x4 tr_read(int vb) {
  s16x4 r; asm volatile("ds_read_b64_tr_b16 %0, %1 offset:%2" : "=&v"(r) : "v"(vb), "i"(OFF) : "memory"); return r;
}
template <int D0> __device__ __forceinline__ void pv_one(f32x16& od, int vb, bf16x8 pa0, bf16x8 pa1, bf16x8 pa2, bf16x8 pa3) {
  const s16x4 l0 = tr_read<v_rd_off(D0, 0, 0)>(vb), h0 = tr_read<v_rd_off(D0, 0, 1)>(vb), l1 = tr_read<v_rd_off(D0, 1, 0)>(vb), h1 = tr_read<v_rd_off(D0, 1, 1)>(vb);
  const s16x4 l2 = tr_read<v_rd_off(D0, 2, 0)>(vb), h2 = tr_read<v_rd_off(D0, 2, 1)>(vb), l3 = tr_read<v_rd_off(D0, 3, 0)>(vb), h3 = tr_read<v_rd_off(D0, 3, 1)>(vb);
  asm volatile("s_waitcnt lgkmcnt(0)" ::: "memory"); SBAR();
#define PK(L, H) (bf16x8){L[0], L[1], L[2], L[3], H[0], H[1], H[2], H[3]}
  od = __builtin_amdgcn_mfma_f32_32x32x16_bf16(pa0, PK(l0, h0), od, 0, 0, 0);
  od = __builtin_amdgcn_mfma_f32_32x32x16_bf16(pa1, PK(l1, h1), od, 0, 0, 0);
  od = __builtin_amdgcn_mfma_f32_32x32x16_bf16(pa2, PK(l2, h2), od, 0, 0, 0);
  od = __builtin_amdgcn_mfma_f32_32x32x16_bf16(pa3, PK(l3, h3), od, 0, 0, 0);
#undef PK
}
__device__ __forceinline__ void pv_d0(f32x16* o, int vb, bf16x8 pa0, bf16x8 pa1, bf16x8 pa2, bf16x8 pa3) {
  pv_one<0>(o[0], vb, pa0, pa1, pa2, pa3); pv_one<1>(o[1], vb, pa0, pa1, pa2, pa3); pv_one<2>(o[2], vb, pa0, pa1, pa2, pa3); pv_one<3>(o[3], vb, pa0, pa1, pa2, pa3);
}
__device__ __forceinline__ void attn_dense_body(const bf16_t* __restrict__ Qb, const bf16_t* __restrict__ Kh, const bf16_t* __restrict__ Vh,
                                                bf16_t* __restrict__ Ob, int seq, char* lds) {
  constexpr int SDEPTH = 2;
  const int tid = tid_opaque(), wid = tid >> 6, lane = tid & 63, r32 = lane & 31, hi = lane >> 5;
  bf16_t* V_lds = (bf16_t*)lds; bf16_t* K_lds = (bf16_t*)(lds + 2 * SHM_V);
  float* ws = (float*)(lds + 2 * SHM_V + 2 * SHM_K) + wid * 64; float* li_l = ws; float* al_l = ws + 32;
  float m_reg = -1e30f, l_reg = 0; f32x16 o[4] = {}; bf16x8 qr[8];
  const bf16_t* Qw = Qb + (long)(wid * QBLK + r32) * LDQ + hi * 8;
#pragma unroll
  for (int d0 = 0; d0 < 8; ++d0) qr[d0] = *reinterpret_cast<const bf16x8*>(Qw + d0 * 16);
  const int sr = tid >> 4, sc = (tid & 15) * 8, vst0 = v_st(sr, sc), vst1 = v_st(32 + sr, sc);
  const int vb0 = (int)(uintptr_t)V_lds + v_rd_base(lane);
  struct { bf16x8 vs0, vs1, ks0, ks1; } sr_[SDEPTH];
#define SLOAD(i, k0) do { sr_[i].vs0 = *reinterpret_cast<const bf16x8*>(&Vh[(long)((k0) + sr) * LDK + sc]); sr_[i].vs1 = *reinterpret_cast<const bf16x8*>(&Vh[(long)((k0) + 32 + sr) * LDK + sc]); \
    sr_[i].ks0 = *reinterpret_cast<const bf16x8*>(&Kh[(long)((k0) + sr) * LDK + sc]); sr_[i].ks1 = *reinterpret_cast<const bf16x8*>(&Kh[(long)((k0) + 32 + sr) * LDK + sc]); } while (0)
#define SWRITE(b, i) do { *(bf16x8*)((char*)V_lds + (b) * SHM_V + vst0) = sr_[i].vs0;          \
    *(bf16x8*)((char*)V_lds + (b) * SHM_V + vst1) = sr_[i].vs1; int kc = sc * 2;               \
    *(bf16x8*)((char*)K_lds + (b) * SHM_K + KSWZ(sr, kc)) = sr_[i].ks0;                       \
    *(bf16x8*)((char*)K_lds + (b) * SHM_K + KSWZ(32 + sr, kc)) = sr_[i].ks1; } while (0)
#define SWAIT() do { asm volatile("s_waitcnt vmcnt(4)" ::: "memory"); } while (0)
#define RESC(a) do { if (__any((a) < 1.f)) { if (hi == 0) al_l[r32] = (a); asm volatile("s_waitcnt lgkmcnt(0)" ::: "memory"); \
    for (int d = 0; d < 4; ++d) for (int r = 0; r < 16; ++r) o[d][r] *= al_l[crow(r, hi)]; } } while (0)
  f32x16 pA0, pA1, pB0, pB1; float mnA, mnB, alA, alB; bf16x8 pa0, pa1, pa2, pa3; const int NT = seq / KVBLK;
  constexpr int SE = 0, SO = SDEPTH - 1;
  SLOAD(SE, 0); asm volatile("s_waitcnt vmcnt(0)" ::: "memory"); SWRITE(0, SE); __syncthreads();
  qkt(pA0, pA1, K_lds, qr, r32, hi); partialSM(pA0, pA1, m_reg, mnA, alA);
  SLOAD(SO, KVBLK); if (2 < NT) SLOAD(SE, 2 * KVBLK);
  SWAIT(); SWRITE(1, SO); __syncthreads();
  for (int j = 1; j + 1 < NT; j += 2) {
    SBAR(); qkt(pB0, pB1, (bf16_t*)((char*)K_lds + SHM_K), qr, r32, hi);
    finishSM(pA0, pA1, alA, l_reg, pa0, pa1, pa2, pa3); SBAR();
    SLOAD(SO, (j + SDEPTH) * KVBLK); SBAR();
    pv_d0(o, vb0, pa0, pa1, pa2, pa3); partialSM(pB0, pB1, m_reg, mnB, alB);
    __syncthreads(); SWAIT(); SWRITE(0, SE);
    RESC(alB); __syncthreads();
    SBAR(); qkt(pA0, pA1, K_lds, qr, r32, hi);
    finishSM(pB0, pB1, alB, l_reg, pa0, pa1, pa2, pa3); SBAR();
    if (j + 3 < NT) SLOAD(SE, (j + 1 + SDEPTH) * KVBLK); SBAR();
    pv_d0(o, vb0 + (int)SHM_V, pa0, pa1, pa2, pa3); partialSM(pA0, pA1, m_reg, mnA, alA);
    __syncthreads(); SWAIT(); SWRITE(1, SO);
    RESC(alA); __syncthreads();
  }
  SBAR(); qkt(pB0, pB1, (bf16_t*)((char*)K_lds + SHM_K), qr, r32, hi);
  finishSM(pA0, pA1, alA, l_reg, pa0, pa1, pa2, pa3); SBAR();
  pv_d0(o, vb0, pa0, pa1, pa2, pa3); partialSM(pB0, pB1, m_reg, mnB, alB);
  __syncthreads(); RESC(alB);
  finishSM(pB0, pB1, alB, l_reg, pa0, pa1, pa2, pa3); SBAR();
  pv_d0(o, vb0 + (int)SHM_V, pa0, pa1, pa2, pa3);
  if (hi == 0) li_l[r32] = l_reg; asm volatile("s_waitcnt lgkmcnt(0)" ::: "memory");
  float rli[16];
#pragma unroll
  for (int r = 0; r < 16; ++r) rli[r] = __builtin_amdgcn_rcpf(li_l[crow(r, hi)]);
  bf16_t* Ow = Ob + (long)(wid * QBLK) * LDO;
#pragma unroll
  for (int r = 0; r < 16; ++r) { int orow = crow(r, hi);
    for (int d0 = 0; d0 < 4; ++d0) Ow[(long)orow * LDO + d0 * 32 + r32] = (bf16_t)f2bf(o[d0][r] * rli[r]); }
  asm volatile("s_waitcnt vmcnt(0) lgkmcnt(0)" ::: "memory");
  __syncthreads();
#undef SLOAD
#undef SWRITE
#undef SWAIT
#undef RESC
}
}

struct Params;
typedef const __attribute__((address_space(4))) Params& KPR;
struct Params {
    const float* x_prompt; const float* x_sample; const float* c_prompt; const float* c_sample;
    const float* norm1_g; const float* norm2_g; const float* w_ada; const float* b_ada;
    const float* fnet_w_o; const float* attn_w_qkv; const float* attn_q_g; const float* attn_k_g; const float* attn_w_o;
    const float* sgu_w_in; const float* sgu_ln_g; const float* sgu_ln_b; const float* sgu_w_s; const float* sgu_b_s; const float* sgu_w_o;
    const float* ffn_w_gu; const float* ffn_w_down; const float* final_g;
    float* out; unsigned char* ws;
    int ph_lo, ph_hi;
};

enum { K_PREP = 0, K_NORM, K_CHANDFT, K_SEQDFT, K_RESID, K_GU, K_QKV, K_QKROPE, K_ATTN, K_WIN, K_SGU, K_FINAL, K_FFT2 };
struct PhaseDesc { unsigned char kind, layer, aux; };
constexpr int NPH = 33;
__device__ const PhaseDesc PHASES[NPH] = {
    {K_PREP, 0, 0},
    {K_NORM, 0, 0}, {K_CHANDFT, 0, 0}, {K_SEQDFT, 0, 0}, {K_FFT2, 0, 0}, {K_RESID, 0, 0}, {K_NORM, 0, 1}, {K_GU, 0, 0}, {K_RESID, 0, 4},
    {K_NORM, 1, 0}, {K_QKV, 1, 0}, {K_QKROPE, 1, 0}, {K_ATTN, 1, 0}, {K_RESID, 1, 2}, {K_NORM, 1, 1}, {K_GU, 1, 0}, {K_RESID, 1, 4},
    {K_NORM, 2, 0}, {K_WIN, 2, 0}, {K_SGU, 2, 0}, {K_RESID, 2, 3}, {K_NORM, 2, 1}, {K_GU, 2, 0}, {K_RESID, 2, 4},
    {K_NORM, 3, 0}, {K_CHANDFT, 3, 0}, {K_SEQDFT, 3, 0}, {K_FFT2, 3, 0}, {K_RESID, 3, 1}, {K_NORM, 3, 1}, {K_GU, 3, 0}, {K_RESID, 3, 4},
    {K_FINAL, 0, 0}};

__device__ __forceinline__ void transpose_item(const float* W, int K, int N, bf16_t* WT, int gu, LAS float* scr, int item, int lane) {
    const int nblk = N / 32, kb = item / nblk, nb = item % nblk, k0 = 64 * kb, n0 = 32 * nb;
#pragma unroll 8
    for (int i = 0; i < 32; ++i) { const int kk = 2 * i + (lane >> 5); scr[kk * 33 + (lane & 31)] = W[(size_t)(k0 + kk) * N + n0 + (lane & 31)]; }
    LDS_WAIT(); asm volatile("" ::: "memory");
    int d0 = n0;
    if (gu) { const int half = n0 / FF, j = n0 - half * FF; d0 = 256 * (j / 128) + 128 * half + (j % 128); }
    const int c = lane & 7;
#pragma unroll
    for (int j = 0; j < 4; ++j) { const int n = (lane >> 3) + 8 * j; const LAS float* s = scr + (8 * c) * 33 + n;
        u32x4 o; o.x = pk2(s[0 * 33], s[1 * 33]); o.y = pk2(s[2 * 33], s[3 * 33]); o.z = pk2(s[4 * 33], s[5 * 33]); o.w = pk2(s[6 * 33], s[7 * 33]);
        *(u32x4*)(WT + (size_t)(d0 + n) * K + k0 + 8 * c) = o; }
    LDS_WAIT(); asm volatile("" ::: "memory");
}

__device__ __forceinline__ void phase_prep(KPR p, LAS unsigned char* lds, int G) {
    const int tid = tid_opaque(), lane = tid & 63, wave = tid >> 6;
    unsigned char* ws = p.ws;
    for (int item = blockIdx.x; item < 4 * 48; item += G) {
        const int layer = item / 48, col0 = (item % 48) * 128;
        LAS float* csT = (LAS float*)lds;
        for (int idx = tid; idx < 32 * 1024; idx += NTHR) { const int b = idx >> 10, k = idx & 1023;
            const float c = b < 16 ? p.c_prompt[b * 1024 + k] : p.c_sample[(b - 16) * 1024 + k];
            csT[k * 32 + b] = c / (1.0f + __expf(-c)); }
        __syncthreads();
        float acc[32][2];
#pragma unroll
        for (int b = 0; b < 32; ++b) { acc[b][0] = 0.f; acc[b][1] = 0.f; }
        const float* wp = p.w_ada + ((size_t)layer * 1024 + wave * 128) * NMOD + col0 + 2 * lane;
#pragma unroll 4
        for (int kk = 0; kk < 128; ++kk) { const f32x2 wv = *(const f32x2*)(wp + (size_t)kk * NMOD); const LAS float* cr = csT + (wave * 128 + kk) * 32;
#pragma unroll
            for (int b = 0; b < 32; ++b) { const float cv = cr[b]; acc[b][0] += cv * wv.x; acc[b][1] += cv * wv.y; } }
        __syncthreads();
        LAS float* part = (LAS float*)lds;
#pragma unroll
        for (int b = 0; b < 32; ++b) *(LAS f32x2*)(part + (wave * 32 + b) * 128 + 2 * lane) = (f32x2){acc[b][0], acc[b][1]};
        __syncthreads();
        for (int o = tid; o < 32 * 128; o += NTHR) { const int b = o >> 7, cc = o & 127; float s = p.b_ada[layer * NMOD + col0 + cc];
#pragma unroll
            for (int w = 0; w < 8; ++w) s += part[(w * 32 + b) * 128 + cc];
            ((float*)(ws + WS_MOD))[((size_t)layer * 32 + b) * NMOD + col0 + cc] = s; }
        __syncthreads();
    }
    __syncthreads();
    {
        LAS float* scr = (LAS float*)(lds + wave * 16384);
        const int gw = blockIdx.x * NWAVES + wave, NGW = G * NWAVES;
        constexpr int I_SQ = (D / 64) * (D / 32), I_QKV = (D / 64) * (NQKV / 32), I_WIN = (D / 64) * (2048 / 32), I_GU = (D / 64) * (2 * FF / 32), I_DN = (FF / 64) * (D / 32);
        constexpr int NITEMS = 4 * I_SQ + I_QKV + I_WIN + 4 * I_GU + 4 * I_DN;
        for (int it = gw; it < NITEMS; it += NGW) {
            int r = it;
            if (r < 2 * I_SQ) { const int j = r / I_SQ; transpose_item(p.fnet_w_o + (size_t)j * D * D, D, D, (bf16_t*)(ws + WS_FNETW) + (size_t)j * D * D, 0, scr, r % I_SQ, lane); continue; } r -= 2 * I_SQ;
            if (r < I_SQ) { transpose_item(p.attn_w_o, D, D, (bf16_t*)(ws + WS_WAO), 0, scr, r, lane); continue; } r -= I_SQ;
            if (r < I_SQ) { transpose_item(p.sgu_w_o, D, D, (bf16_t*)(ws + WS_WSO), 0, scr, r, lane); continue; } r -= I_SQ;
            if (r < I_QKV) { transpose_item(p.attn_w_qkv, D, NQKV, (bf16_t*)(ws + WS_WQKV), 0, scr, r, lane); continue; } r -= I_QKV;
            if (r < I_WIN) { transpose_item(p.sgu_w_in, D, 2048, (bf16_t*)(ws + WS_WIN), 0, scr, r, lane); continue; } r -= I_WIN;
            if (r < 4 * I_GU) { const int j = r / I_GU; transpose_item(p.ffn_w_gu + (size_t)j * D * 2 * FF, D, 2 * FF, (bf16_t*)(ws + WS_WGU) + (size_t)j * D * 2 * FF, 1, scr, r % I_GU, lane); continue; } r -= 4 * I_GU;
            { const int j = r / I_DN; transpose_item(p.ffn_w_down + (size_t)j * FF * D, FF, D, (bf16_t*)(ws + WS_WDN) + (size_t)j * FF * D, 0, scr, r % I_DN, lane); }
        }
    }
    const size_t gt = (size_t)blockIdx.x * NTHR + tid, NGT = (size_t)G * NTHR;
    for (size_t i = gt; i < 8 * 128 * 128; i += NGT) ((bf16_t*)(ws + WS_WSB))[i] = (bf16_t)f2bf(p.sgu_w_s[i]);
    for (size_t i = gt; i < 512 * 256; i += NGT) { const int m = (int)(i >> 8), c = (int)(i & 255), l = m & 255; const float a = (float)((l * c) & 255) * (1.0f / 128.0f);
        ((bf16_t*)(ws + WS_DFTC))[i] = (bf16_t)f2bf(m < 256 ? cospif(a) : sinpif(a)); }
    for (int part = 0; part < 2; ++part) {
        const int L = part ? 8 : 16, S_ = part ? SS : SP; bf16_t* M1 = (bf16_t*)(ws + (part ? WS_M1S : WS_M1P)); const float inv = 2.0f / (float)S_;
        for (size_t i = gt; i < (size_t)L * 512 * 512 / 8; i += NGT) { const int s_lo = (int)(i >> 15), m = (int)(i >> 6) & 511, j0 = (int)(i & 63) * 8, ri = m >> 8, k_lo = m & 255; float v[8];
#pragma unroll
            for (int e = 0; e < 8; ++e) { const int j = j0 + e, cs = j >> 8, s_hi = j & 255; const float a = (float)((k_lo * (s_lo + L * s_hi)) & (S_ - 1)) * inv;
                const float cv = cospif(a), sv = sinpif(a); v[e] = ri == 0 ? (cs == 0 ? cv : -sv) : (cs == 0 ? sv : cv); }
            u32x4 o; o.x = pk2(v[0], v[1]); o.y = pk2(v[2], v[3]); o.z = pk2(v[4], v[5]); o.w = pk2(v[6], v[7]);
            *(u32x4*)(M1 + i * 8) = o; }
    }
}

template <int L> __device__ __forceinline__ void fft2_part(const bf16_t* Y, bf16_t* F, float scale, int G, int tid) {
    constexpr float C16[16] = {1.0f, 0.92387953251f, 0.70710678119f, 0.38268343237f, 0.0f, -0.38268343237f, -0.70710678119f, -0.92387953251f, -1.0f, -0.92387953251f, -0.70710678119f, -0.38268343237f, 0.0f, 0.38268343237f, 0.70710678119f, 0.92387953251f};
    constexpr float S16[16] = {0.0f, 0.38268343237f, 0.70710678119f, 0.92387953251f, 1.0f, 0.92387953251f, 0.70710678119f, 0.38268343237f, 0.0f, -0.38268343237f, -0.70710678119f, -0.92387953251f, -1.0f, -0.92387953251f, -0.70710678119f, -0.38268343237f};
    constexpr int LSH = (L == 16) ? 4 : 3, SLEN = 256 * L;
    for (unsigned id = blockIdx.x * NTHR + tid; id < 16u * 256u * 256u; id += (unsigned)G * NTHR) {
        const unsigned chq = id & 255u, k_lo = (id >> 8) & 255u, b = id >> 16;
        float yr[L][4], yi[L][4];
#pragma unroll
        for (int sl = 0; sl < L; ++sl) { const bf16_t* yp = Y + ((size_t)(((b << LSH) + sl) * 512u + k_lo)) * 1024 + 4 * chq;
            const u32x2 a = *(const u32x2*)yp, c = *(const u32x2*)(yp + 256 * 1024);
            yr[sl][0] = __builtin_bit_cast(float, a.x << 16); yr[sl][1] = __builtin_bit_cast(float, a.x & 0xffff0000u); yr[sl][2] = __builtin_bit_cast(float, a.y << 16); yr[sl][3] = __builtin_bit_cast(float, a.y & 0xffff0000u);
            yi[sl][0] = __builtin_bit_cast(float, c.x << 16); yi[sl][1] = __builtin_bit_cast(float, c.x & 0xffff0000u); yi[sl][2] = __builtin_bit_cast(float, c.y << 16); yi[sl][3] = __builtin_bit_cast(float, c.y & 0xffff0000u); }
#pragma unroll
        for (int kh = 0; kh < L; ++kh) { float acc[4] = {0.f, 0.f, 0.f, 0.f};
#pragma unroll
            for (int sl = 0; sl < L; ++sl) { const int t = ((kh * sl) % L) * (16 / L); const float cv = C16[t], sv = S16[t];
#pragma unroll
                for (int e = 0; e < 4; ++e) acc[e] += cv * yr[sl][e] - sv * yi[sl][e]; }
            u32x2 w; w.x = pk2(acc[0] * scale, acc[1] * scale); w.y = pk2(acc[2] * scale, acc[3] * scale);
            *(u32x2*)(F + ((size_t)(b * SLEN + k_lo + 256 * kh)) * 1024 + 4 * chq) = w; }
    }
}
__device__ __forceinline__ void phase_fft2(KPR p, int G) {
    const int tid = tid_opaque();
    fft2_part<16>((const bf16_t*)p.out, (bf16_t*)(p.ws + WS_ZT), 0.015625f, G, tid);
    fft2_part<8>((const bf16_t*)p.out + (size_t)TP * 2048, (bf16_t*)(p.ws + WS_ZT) + (size_t)TP * D, 0.022097086912079608f, G, tid);
}

__device__ __forceinline__ void phase_norm(KPR p, int layer, int which, int G) {
    const int tid = tid_opaque(), lane = tid & 63, wave = tid >> 6;
    const bool first = (layer == 0 && which == 0);
    const float* gam = (which ? p.norm2_g : p.norm1_g) + layer * D;
    const float* mod = (const float*)(p.ws + WS_MOD) + (size_t)layer * 32 * NMOD + (which ? 3 : 0) * D;
    bf16_t* H = (bf16_t*)p.out;
    const float* xP = p.x_prompt; const float* xS = p.x_sample - (size_t)TP * D; const _Float16* X16 = (const _Float16*)(p.ws + WS_X16);
    f32x4 gv[4];
#pragma unroll
    for (int j = 0; j < 4; ++j) gv[j] = *(const f32x4*)(gam + 4 * (lane + 64 * j));
    constexpr int UNR = 3;
    const int stride = G * NWAVES;
    for (int row0 = blockIdx.x * NWAVES + wave; row0 < T; row0 += UNR * stride) {
        f32x4 v[UNR][4]; float s[UNR];
#pragma unroll
        for (int u = 0; u < UNR; ++u) { const int row = row0 + u * stride; s[u] = 0.f;
            if (row < T) {
                if (first) { const float* xr = (row < TP ? xP : xS) + (size_t)row * D;
#pragma unroll
                    for (int j = 0; j < 4; ++j) v[u][j] = *(const f32x4*)(xr + 4 * (lane + 64 * j)); }
                else { const _Float16* xr = X16 + (size_t)row * D;
#pragma unroll
                    for (int j = 0; j < 4; ++j) { const h16x4 hv = *(const h16x4*)(xr + 4 * (lane + 64 * j)); v[u][j] = (f32x4){(float)hv[0], (float)hv[1], (float)hv[2], (float)hv[3]}; } } } }
#pragma unroll
        for (int u = 0; u < UNR; ++u) { const int row = row0 + u * stride;
            if (row < T) {
#pragma unroll
                for (int j = 0; j < 4; ++j) s[u] += (v[u][j].x * v[u][j].x + v[u][j].y * v[u][j].y) + (v[u][j].z * v[u][j].z + v[u][j].w * v[u][j].w);
                const float rstd = rsqrtf(wave_sum(s[u]) * (1.0f / D) + EPS);
                const float* mr = mod + (size_t)seq_of(row) * NMOD;
#pragma unroll
                for (int j = 0; j < 4; ++j) { const int c = 4 * (lane + 64 * j); const f32x4 sh = *(const f32x4*)(mr + c), sc = *(const f32x4*)(mr + D + c);
                    const f32x4 y = (v[u][j] * rstd) * gv[j]; const f32x4 h = y * (sc + 1.0f) + sh;
                    u32x2 w; w.x = pk2(h.x, h.y); w.y = pk2(h.z, h.w);
                    *(u32x2*)(H + (size_t)row * D + c) = w; } } }
    }
}

__device__ __forceinline__ void phase_final(KPR p, int G) {
    const int tid = tid_opaque(), lane = tid & 63, wave = tid >> 6;
    f32x4 gv[4];
#pragma unroll
    for (int j = 0; j < 4; ++j) gv[j] = *(const f32x4*)(p.final_g + 4 * (lane + 64 * j));
    constexpr int UNR = 3;
    const int stride = G * NWAVES;
    for (int row0 = blockIdx.x * NWAVES + wave; row0 < T; row0 += UNR * stride) {
        f32x4 v[UNR][4];
#pragma unroll
        for (int u = 0; u < UNR; ++u) { const int row = row0 + u * stride;
            if (row < T) {
#pragma unroll
                for (int j = 0; j < 4; ++j) { const h16x4 hv = *(const h16x4*)((const _Float16*)(p.ws + WS_X16) + (size_t)row * D + 4 * (lane + 64 * j)); v[u][j] = (f32x4){(float)hv[0], (float)hv[1], (float)hv[2], (float)hv[3]}; } } }
#pragma unroll
        for (int u = 0; u < UNR; ++u) { const int row = row0 + u * stride;
            if (row < T) { float s = 0.f;
#pragma unroll
                for (int j = 0; j < 4; ++j) s += (v[u][j].x * v[u][j].x + v[u][j].y * v[u][j].y) + (v[u][j].z * v[u][j].z + v[u][j].w * v[u][j].w);
                const float rstd = rsqrtf(wave_sum(s) * (1.0f / D) + EPS);
#pragma unroll
                for (int j = 0; j < 4; ++j) *(f32x4*)(p.out + (size_t)row * D + 4 * (lane + 64 * j)) = (v[u][j] * rstd) * gv[j]; } }
    }
}

__device__ __forceinline__ void phase_qkrope(KPR p, int G) {
    const int tid = tid_opaque(), lane = tid & 63, wave = tid >> 6;
    bf16_t* QKVb = (bf16_t*)(p.ws + WS_BIG);
    const int i0 = 2 * (lane & 15);
    const float f0 = 1.0f / powf(10000.0f, (float)(2 * i0) / 64.0f), f1 = 1.0f / powf(10000.0f, (float)(2 * (i0 + 1)) / 64.0f);
    const bool x2 = (lane & 31) >= 16, colhalf = lane >= 32;
    const f32x2 qg = *(const f32x2*)(p.attn_q_g + 2 * lane), kg = *(const f32x2*)(p.attn_k_g + 2 * lane);
    constexpr int UNR = 3;
    const int stride = G * NWAVES;
    for (int row0 = blockIdx.x * NWAVES + wave; row0 < T; row0 += UNR * stride) {
        unsigned raw[UNR][10];
#pragma unroll
        for (int u = 0; u < UNR; ++u) { const int row = row0 + u * stride;
            if (row < T) { const unsigned* rp = (const unsigned*)(QKVb + (size_t)row * NQKV) + lane;
#pragma unroll
                for (int h = 0; h < 10; ++h) raw[u][h] = rp[h * 64]; } }
#pragma unroll
        for (int u = 0; u < UNR; ++u) { const int row = row0 + u * stride;
            if (row < T) {
                const int sq = seq_of(row), t = row - seq_start(sq);
                const float pos = (float)(colhalf ? (t & 63) : (t >> 6));
                float s0, c0, s1, c1; sincosf(pos * f0, &s0, &c0); sincosf(pos * f1, &s1, &c1);
                unsigned* rp = (unsigned*)(QKVb + (size_t)row * NQKV) + lane;
#pragma unroll
                for (int h = 0; h < 10; ++h) {
                    const float v0 = bf2f((unsigned short)(raw[u][h] & 0xffffu)), v1 = bf2f((unsigned short)(raw[u][h] >> 16));
                    const float rstd = rsqrtf(wave_sum(v0 * v0 + v1 * v1) * (1.0f / 128.0f) + EPS);
                    const f32x2 g = h < 8 ? qg : kg;
                    const float y0 = v0 * rstd * g.x, y1 = v1 * rstd * g.y;
                    const float z0 = __shfl_xor(y0, 16), z1 = __shfl_xor(y1, 16);
                    const float o0 = x2 ? (y0 * c0 + z0 * s0) : (y0 * c0 - z0 * s0);
                    const float o1 = x2 ? (y1 * c1 + z1 * s1) : (y1 * c1 - z1 * s1);
                    rp[h * 64] = pk2(o0, o1);
                } } }
    }
}

__device__ __forceinline__ void phase_attn(KPR p, char* lds, int G) {
    const bf16_t* QKVb = (const bf16_t*)(p.ws + WS_BIG); bf16_t* O = (bf16_t*)p.out;
    const int bx = blockIdx.x, vcu = (G % 8 == 0) ? (bx % 8) * (G / 8) + bx / 8 : bx;
    for (int u = vcu; u < 2048 + 1024; u += G) {
        int b, kvh, g, qb, S;
        if (u < 2048) { b = u >> 7; const int r = u & 127; kvh = r >> 6; g = (r >> 4) & 3; qb = r & 15; S = SP; }
        else { const int v = u - 2048; b = 16 + (v >> 6); const int r = v & 63; kvh = r >> 5; g = (r >> 3) & 3; qb = r & 7; S = SS; }
        const int h = kvh * 4 + g; const size_t r0 = (size_t)seq_start(b);
        att::attn_dense_body(QKVb + (r0 + (size_t)qb * 256) * NQKV + h * 128, QKVb + r0 * NQKV + 1024 + kvh * 128, QKVb + r0 * NQKV + 1280 + kvh * 128,
                             O + (r0 + (size_t)qb * 256) * D + h * 128, S, lds);
    }
}

__device__ __forceinline__ void phase_sgu(KPR p, char* lds, int G) {
    const int tid = tid_opaque(), lane = tid & 63, wave = tid >> 6, r32 = lane & 31, hi = lane >> 5;
    const bf16_t* UV = (const bf16_t*)(p.ws + WS_BIG); bf16_t* OUT = (bf16_t*)p.out; const bf16_t* WSB = (const bf16_t*)(p.ws + WS_WSB);
    constexpr int VS = 136;
    bf16_t* VT = (bf16_t*)lds;
    float* st = (float*)(lds + 128 * VS * 2);
    for (int ci = blockIdx.x; ci < T / 128; ci += G) {
        const size_t r0 = (size_t)ci * 128;
        for (int rb = 0; rb < 16; rb += 8) {
            bf16x8 va[8], vb[8];
#pragma unroll
            for (int rr = 0; rr < 8; ++rr) { const bf16_t* vp = UV + (r0 + wave * 16 + rb + rr) * 2048 + 1024 + 8 * lane; va[rr] = *(const bf16x8*)vp; vb[rr] = *(const bf16x8*)(vp + 512); }
#pragma unroll
            for (int rr = 0; rr < 8; ++rr) { const int j = wave * 16 + rb + rr; float x[16]; float s = 0.f;
#pragma unroll
                for (int e = 0; e < 8; ++e) { x[e] = bf2f((unsigned short)va[rr][e]); x[8 + e] = bf2f((unsigned short)vb[rr][e]); }
#pragma unroll
                for (int e = 0; e < 16; ++e) s += x[e];
                const float mean = wave_sum(s) * (1.0f / 1024.0f); float q = 0.f;
#pragma unroll
                for (int e = 0; e < 16; ++e) { const float d = x[e] - mean; q += d * d; }
                const float rstd = rsqrtf(wave_sum(q) * (1.0f / 1024.0f) + EPS);
                if (lane == 0) { st[2 * j] = mean; st[2 * j + 1] = rstd; } }
        }
        __syncthreads();
        for (int g = 0; g < 8; ++g) {
            { const int j = tid & 127; const float mean = st[2 * j], rstd = st[2 * j + 1];
#pragma unroll
              for (int it = 0; it < 4; ++it) { const int c0 = 8 * ((tid >> 7) + 4 * it);
                const bf16x8 a = *(const bf16x8*)(UV + (r0 + j) * 2048 + 1024 + g * 128 + c0);
#pragma unroll
                for (int e = 0; e < 8; ++e) { const int c = c0 + e; const float vn = (bf2f((unsigned short)a[e]) - mean) * rstd * p.sgu_ln_g[g * 128 + c] + p.sgu_ln_b[g * 128 + c];
                    VT[c * VS + j] = (bf16_t)f2bf(vn); } } }
            __syncthreads();
            const int it_ = wave >> 1, ct0 = (wave & 1) * 2;
            f32x16 acc0 = {}, acc1 = {};
            const bf16_t* ap = WSB + (size_t)g * 16384 + (32 * it_ + r32) * 128 + 8 * hi;
#pragma unroll
            for (int ks = 0; ks < 8; ++ks) {
                const bf16x8 af = *(const bf16x8*)(ap + 16 * ks);
                const bf16x8 b0 = *(const bf16x8*)(VT + (32 * ct0 + r32) * VS + 16 * ks + 8 * hi);
                const bf16x8 b1 = *(const bf16x8*)(VT + (32 * (ct0 + 1) + r32) * VS + 16 * ks + 8 * hi);
                acc0 = __builtin_amdgcn_mfma_f32_32x32x16_bf16(af, b0, acc0, 0, 0, 0);
                acc1 = __builtin_amdgcn_mfma_f32_32x32x16_bf16(af, b1, acc1, 0, 0, 0);
            }
#pragma unroll
            for (int r = 0; r < 16; ++r) { const int i = 32 * it_ + att::crow(r, hi); const float bs = p.sgu_b_s[g * 128 + i];
                const size_t ro = r0 + i; const int c_0 = g * 128 + 32 * ct0 + r32, c_1 = c_0 + 32;
                const float u0 = bf2f(UV[ro * 2048 + c_0]), u1 = bf2f(UV[ro * 2048 + c_1]);
                OUT[ro * D + c_0] = (bf16_t)f2bf(u0 * (acc0[r] + bs)); OUT[ro * D + c_1] = (bf16_t)f2bf(u1 * (acc1[r] + bs)); }
            __syncthreads();
        }
    }
}

#define XB_TMO      128
#define XB_XCNT(j)  (256  + 64 * (j))
#define XB_XSUB(j)  (1280 + 64 * (j))
#define XB_XGEN(j)  (2304 + 64 * (j))
#define XB_TOP      3328
#define XB_TOPGEN   3392
#define XCD_BAR_WORDS 3456
#define XB_SPIN_CAP (1u << 22)
__device__ __forceinline__ unsigned xb_ld(unsigned* p)              { return __hip_atomic_load(p, __ATOMIC_RELAXED, __HIP_MEMORY_SCOPE_AGENT); }
__device__ __forceinline__ unsigned xb_add(unsigned* p, unsigned v) { return __hip_atomic_fetch_add(p, v, __ATOMIC_RELAXED, __HIP_MEMORY_SCOPE_AGENT); }
__device__ __forceinline__ unsigned xb_xcc_id() { return (unsigned)__builtin_amdgcn_s_getreg((3 << 11) | 20) & 0xFu; }
#define XB_SPIN(cond, bar) do { unsigned _sp = 0; while (cond) { __builtin_amdgcn_s_sleep(1); \
    if ((++_sp & 255u) == 0u) { if (xb_ld(&(bar)[XB_TMO])) break; if (_sp > XB_SPIN_CAP) { atomicAdd(&(bar)[XB_TMO], 1u); break; } } } } while (0)
struct XcdBarrier { unsigned* bar; unsigned x; volatile LAS unsigned* st; };
__device__ __forceinline__ XcdBarrier xcd_barrier_post(unsigned* bar, volatile LAS unsigned* st) {
    XcdBarrier b; b.bar = bar; b.x = xb_xcc_id(); b.st = st;
    if (threadIdx.x == 0) (void)xb_add(&bar[XB_XCNT(b.x)], 1u);
    return b;
}
__device__ __forceinline__ void xcd_barrier_complete(unsigned* bar, unsigned x, unsigned& nloc, unsigned& nx) {
    const unsigned G = gridDim.x * gridDim.y * gridDim.z;
    unsigned sum, cnt, mine, sp = 0u;
    for (;;) {
        sum = 0u; cnt = 0u; mine = 0u;
#pragma unroll
        for (unsigned j = 0; j < 16; ++j) { const unsigned c = xb_ld(&bar[XB_XCNT(j)]); sum += c; cnt += (c > 0u) ? 1u : 0u; mine = (j == x) ? c : mine; }
        if (sum == G) break;
        __builtin_amdgcn_s_sleep(1);
        if ((++sp & 255u) == 0u) { if (xb_ld(&bar[XB_TMO])) break; if (sp > XB_SPIN_CAP) { atomicAdd(&bar[XB_TMO], 1u); break; } }
    }
    nloc = mine > 0u ? mine : 1u; nx = cnt > 0u ? cnt : 1u;
}
__device__ __forceinline__ void xcd_barrier(const XcdBarrier& b) {
    asm volatile("s_waitcnt vmcnt(0)" ::: "memory");
    __syncthreads();
    if (threadIdx.x == 0) {
        unsigned* bar = b.bar;
        __builtin_amdgcn_s_waitcnt(0);
        unsigned nloc = b.st[0], nx = b.st[1];
        if (nloc == 0u) { xcd_barrier_complete(bar, b.x, nloc, nx); b.st[0] = nloc; b.st[1] = nx; }
        const unsigned old = xb_add(&bar[XB_XSUB(b.x)], 1u);
        const unsigned gen = old / nloc;
        if (old + 1u == (gen + 1u) * nloc) {
            __builtin_amdgcn_fence(__ATOMIC_RELEASE, "agent");
            asm volatile("s_waitcnt vmcnt(0)" ::: "memory");
            const unsigned og = xb_add(&bar[XB_TOP], 1u);
            const unsigned tg = og / nx;
            if (og + 1u == (tg + 1u) * nx) xb_add(&bar[XB_TOPGEN], 1u);
            else XB_SPIN(xb_ld(&bar[XB_TOPGEN]) == tg, bar);
            __builtin_amdgcn_fence(__ATOMIC_ACQUIRE, "agent");
            xb_add(&bar[XB_XGEN(b.x)], 1u);
            asm volatile("s_waitcnt vmcnt(0)" ::: "memory");
        } else {
            XB_SPIN(xb_ld(&bar[XB_XGEN(b.x)]) == gen, bar);
            __builtin_amdgcn_fence(__ATOMIC_ACQUIRE, "agent");
            asm volatile("s_waitcnt vmcnt(0)" ::: "memory");
        }
    }
    __syncthreads();
}

__global__ void __launch_bounds__(NTHR, 2) mega_fwd(Params p_arg) {
    extern __shared__ __attribute__((aligned(16))) unsigned char lds[];
    LAS unsigned char* ldsl = (LAS unsigned char*)lds;
    const int G = gridDim.x;
    const __attribute__((address_space(4))) Params* kp = (const __attribute__((address_space(4))) Params*)__builtin_amdgcn_kernarg_segment_ptr();
    const int ph_lo = kp->ph_lo, ph_hi = kp->ph_hi;
    volatile LAS unsigned* xst = (volatile LAS unsigned*)(ldsl + 131072 + 64);
    if (threadIdx.x == 0) { xst[0] = 0u; xst[1] = 0u; }
    __syncthreads();
    XcdBarrier xbar; xbar.bar = (unsigned*)(kp->ws + WS_BAR); xbar.x = 0; xbar.st = xst;
    if (ph_hi - ph_lo > 1) xbar = xcd_barrier_post((unsigned*)(kp->ws + WS_BAR), xst);
    for (int ph = ph_lo; ph < ph_hi; ++ph) {
        asm volatile("" : "+s"(kp));
        KPR p = *kp;
        unsigned char* ws = p.ws;
        const PhaseDesc pd = PHASES[ph];
        const int layer = pd.layer;
        for (int rep = 0; rep < 1 + (((MK_DUP) >> pd.kind) & 1); ++rep)
        switch (pd.kind) {
        case K_PREP: if (EN(K_PREP)) phase_prep(p, ldsl, G); break;
        case K_NORM: if (EN(K_NORM)) phase_norm(p, layer, pd.aux, G); break;
        case K_FINAL: if (EN(K_FINAL)) phase_final(p, G); break;
        case K_QKROPE: if (EN(K_QKROPE)) phase_qkrope(p, G); break;
        case K_ATTN: if (EN(K_ATTN)) phase_attn(p, (char*)lds, G); break;
        case K_SGU: if (EN(K_SGU)) phase_sgu(p, (char*)lds, G); break;
        case K_CHANDFT: if (EN(K_CHANDFT)) {
            for (int part = 0; part < 2; ++part) {
                const int lsh = part ? 3 : 4, S_ = part ? SS : SP;
                pg8::Gemm g{(const bf16_t*)(ws + WS_DFTC), (const bf16_t*)p.out + (part ? (size_t)TP * D : 0), 256, D << lsh, 256, 1, 1, 0, 0,
                            lsh, (1 << lsh) - 1, (size_t)S_ * D * 2, (size_t)D * 2, (size_t)256 * 2};
                pg8::StaticOrder S; S.init(8, 16 << lsh, G, blockIdx.x);
                pg8::EpiChanDft E{(bf16_t*)(ws + WS_ZT) + (part ? (size_t)TP * 2048 : 0)};
                pg8::gemm_phase<pg8::EpiChanDft, pg8::StaticOrder, true, true>(ldsl, g, S, E);
            }
        } break;
        case K_SEQDFT: if (EN(K_SEQDFT)) {
            for (int part = 0; part < 2; ++part) {
                const int L = part ? 8 : 16;
                pg8::Gemm g{(const bf16_t*)(ws + (part ? WS_M1S : WS_M1P)), (const bf16_t*)(ws + WS_ZT) + (part ? (size_t)TP * 2048 : 0), 512, 512, 512, 1, 1, L - 1, (size_t)512 * 512 * 2,
                            0, 0, (size_t)256 * 512 * 2, 0, (size_t)1024 * 512 * 2};
                pg8::StaticOrder S; S.init(16 * L * 2, 4, G, blockIdx.x);
                pg8::EpiBf16<0> E{(bf16_t*)p.out + (part ? (size_t)TP * 2048 : 0), D, 1.0f};
                pg8::gemm_phase<pg8::EpiBf16<0>, pg8::StaticOrder, true, true>(ldsl, g, S, E);
            }
        } break;
        case K_FFT2: if (EN(K_FFT2)) phase_fft2(p, G); break;
        case K_QKV: if (EN(K_QKV)) {
            pg8::Gemm g = pg8::plain_gemm((const bf16_t*)p.out, (const bf16_t*)(ws + WS_WQKV), D, D, D);
            pg8::StaticOrder S; S.init(T / 256, NQKV / 256, G, blockIdx.x);
            pg8::EpiBf16<0> E{(bf16_t*)(ws + WS_BIG), NQKV, 1.0f};
            pg8::gemm_phase<pg8::EpiBf16<0>, pg8::StaticOrder, true, true>(ldsl, g, S, E);
        } break;
        case K_WIN: if (EN(K_WIN)) {
            pg8::Gemm g = pg8::plain_gemm((const bf16_t*)p.out, (const bf16_t*)(ws + WS_WIN), D, D, D);
            pg8::StaticOrder S; S.init(T / 256, 2048 / 256, G, blockIdx.x);
            pg8::EpiBf16<1> E{(bf16_t*)(ws + WS_BIG), 2048, 1.0f};
            pg8::gemm_phase<pg8::EpiBf16<1>, pg8::StaticOrder, true, true>(ldsl, g, S, E);
        } break;
        case K_GU: if (EN(K_GU)) {
            pg8::Gemm g = pg8::plain_gemm((const bf16_t*)p.out, (const bf16_t*)(ws + WS_WGU) + (size_t)layer * D * 2 * FF, D, D, D);
            pg8::StaticOrder S; S.init(T / 256, 2 * FF / 256, G, blockIdx.x);
            pg8::EpiSwiGlu E{(bf16_t*)(ws + WS_BIG)};
            pg8::gemm_phase<pg8::EpiSwiGlu, pg8::StaticOrder, true, true>(ldsl, g, S, E);
        } break;
        case K_RESID: if (EN(K_RESID)) {
            const int aux = pd.aux; const bool first = (layer == 0 && aux != 4);
            const bf16_t* A = aux == 4 ? (const bf16_t*)(ws + WS_BIG) : aux < 2 ? (const bf16_t*)(ws + WS_ZT) : (const bf16_t*)p.out;
            const bf16_t* W = aux == 0 ? (const bf16_t*)(ws + WS_FNETW) : aux == 1 ? (const bf16_t*)(ws + WS_FNETW) + (size_t)D * D : aux == 2 ? (const bf16_t*)(ws + WS_WAO)
                            : aux == 3 ? (const bf16_t*)(ws + WS_WSO) : (const bf16_t*)(ws + WS_WDN) + (size_t)layer * FF * D;
            const int K = aux == 4 ? FF : D;
            pg8::Gemm g = pg8::plain_gemm(A, W, K, K, K);
            pg8::StaticOrder S; S.init(T / 256, D / 256, G, blockIdx.x);
            pg8::EpiResid E{p.x_prompt, p.x_sample - (size_t)TP * D, (_Float16*)(ws + WS_X16), first ? 1 : 0,
                            (const float*)(ws + WS_MOD) + (size_t)layer * 32 * NMOD + (aux == 4 ? 5 : 2) * D};
            pg8::gemm_phase<pg8::EpiResid, pg8::StaticOrder, true, true>(ldsl, g, S, E);
        } break;
        }
        if (ph + 1 < ph_hi) {
            if (ph == ph_lo) { __threadfence(); cg::this_grid().sync(); }
            else xcd_barrier(xbar);
        }
    }
}

extern "C" void kernel_launch(void* const* d_in, const int* in_sizes, int n_in, void* d_out, int out_size, void* d_ws, size_t ws_size, hipStream_t stream) {
    static int grid = 0;
    if (grid == 0) {
        if (n_in != 22 || in_sizes[0] != TP * D || in_sizes[1] != TS * D || out_size != T * D || ws_size < WS_END) {
            fprintf(stderr, "kernel_launch: shape mismatch n_in %d in0 %d in1 %d out %d ws %zu (need %zu)\n", n_in, n_in > 0 ? in_sizes[0] : -1, n_in > 1 ? in_sizes[1] : -1, out_size, ws_size, (size_t)WS_END);
            grid = -1; return; }
        int dev = 0, cus = 0, per_cu = 0;
        if (hipGetDevice(&dev) != hipSuccess || hipDeviceGetAttribute(&cus, hipDeviceAttributeMultiprocessorCount, dev) != hipSuccess) { grid = -1; return; }
        if (hipFuncSetAttribute((const void*)mega_fwd, hipFuncAttributeMaxDynamicSharedMemorySize, LDS_BYTES) != hipSuccess) { fprintf(stderr, "kernel_launch: hipFuncSetAttribute failed\n"); grid = -1; return; }
        if (hipOccupancyMaxActiveBlocksPerMultiprocessor(&per_cu, (const void*)mega_fwd, NTHR, LDS_BYTES) != hipSuccess || per_cu < 1) { fprintf(stderr, "kernel_launch: occupancy query gave %d\n", per_cu); per_cu = 1; }
        (void)hipGetLastError();
        grid = cus * per_cu;
        fprintf(stderr, "kernel_launch: grid %d (cus %d x %d)\n", grid, cus, per_cu);
    }
    if (grid < 0) return;
    Params p{};
    p.x_prompt = (const float*)d_in[0]; p.x_sample = (const float*)d_in[1]; p.c_prompt = (const float*)d_in[2]; p.c_sample = (const float*)d_in[3];
    p.norm1_g = (const float*)d_in[4]; p.norm2_g = (const float*)d_in[5]; p.w_ada = (const float*)d_in[6]; p.b_ada = (const float*)d_in[7];
    p.fnet_w_o = (const float*)d_in[8]; p.attn_w_qkv = (const float*)d_in[9]; p.attn_q_g = (const float*)d_in[10]; p.attn_k_g = (const float*)d_in[11]; p.attn_w_o = (const float*)d_in[12];
    p.sgu_w_in = (const float*)d_in[13]; p.sgu_ln_g = (const float*)d_in[14]; p.sgu_ln_b = (const float*)d_in[15]; p.sgu_w_s = (const float*)d_in[16]; p.sgu_b_s = (const float*)d_in[17]; p.sgu_w_o = (const float*)d_in[18];
    p.ffn_w_gu = (const float*)d_in[19]; p.ffn_w_down = (const float*)d_in[20]; p.final_g = (const float*)d_in[21];
    p.out = (float*)d_out; p.ws = (unsigned char*)d_ws;
#if MK_SINGLE
    if (hipMemsetAsync((char*)d_ws + WS_BAR, 0, BAR_BYTES, stream) != hipSuccess) { fprintf(stderr, "kernel_launch: memset failed\n"); return; }
    p.ph_lo = 0; p.ph_hi = NPH;
    void* args[] = {&p};
    hipError_t e = hipLaunchCooperativeKernel((const void*)mega_fwd, dim3(grid), dim3(NTHR), args, LDS_BYTES, stream);
    if (e != hipSuccess) fprintf(stderr, "kernel_launch: cooperative launch failed: %s (grid %d)\n", hipGetErrorString(e), grid);
#else
    for (int ph = 0; ph < NPH; ++ph) {
        p.ph_lo = ph; p.ph_hi = ph + 1;
        hipLaunchKernelGGL(mega_fwd, dim3(grid), dim3(NTHR), LDS_BYTES, stream, p);
    }
    const hipError_t le = hipPeekAtLastError();
    if (le != hipSuccess) fprintf(stderr, "kernel_launch: launch failed: %s\n", hipGetErrorName(le));
#endif
}
```
